# Optimizing an MI355X kernel written in HIP

```python
import math
import jax, jax.numpy as jnp
from jax import lax
import numpy as np


D_MODEL = 4096
BATCH = 4
SEQ = 2048
DEPTH = 2

HEAD_DIM = 128
N_MIXERS = 4
MIX_WIDTH = D_MODEL
GROUP_WIDTH = MIX_WIDTH // N_MIXERS
N_HEADS = GROUP_WIDTH // HEAD_DIM
MOBA_BLOCK = 256
MOBA_TOPK = 3
MOBA_Q_CHUNK = 64
SB_Q_BLOCK = 128
POOL_WINDOWS = (2, 4, 8, 16)
N_POOL_GROUPS = len(POOL_WINDOWS)
POOL_GROUP_DIM = GROUP_WIDTH // N_POOL_GROUPS
DILATED_PATTERNS = ((128, 1), (512, 4), (2048, 16))
DIL_Q_CHUNK = 64
D_FF = ((8 * D_MODEL + 3 * 256 - 1) // (3 * 256)) * 256
IN_WIDTH = 3 * 3 * GROUP_WIDTH + GROUP_WIDTH
RMS_EPS = 1e-6
NEG_INF = -1e30

kernel_name = "hybrid_moba_stickbreak_pool_dilated_block"


def rms_norm(x, g):
    xf = x.astype(jnp.float32)
    y = xf * lax.rsqrt(jnp.mean(xf * xf, axis=-1, keepdims=True) + RMS_EPS)
    return (y * g.astype(jnp.float32)).astype(x.dtype)


def moba_attention(q, k, v):
    B, H, S, hd = q.shape
    nb = -(-S // MOBA_BLOCK)
    pad = nb * MOBA_BLOCK - S
    kp = jnp.pad(k, ((0, 0), (0, 0), (0, pad), (0, 0))).reshape(B, H, nb, MOBA_BLOCK, hd)
    vp = jnp.pad(v, ((0, 0), (0, 0), (0, pad), (0, 0))).reshape(B, H, nb, MOBA_BLOCK, hd)
    kmean = jnp.mean(kp.astype(jnp.float32), axis=3)
    n_sel = min(MOBA_TOPK, nb - 1)
    scale = hd ** -0.5
    b_idx = jnp.arange(B)[:, None, None, None]
    h_idx = jnp.arange(H)[None, :, None, None]

    def chunk(ci):
        c0 = ci * MOBA_Q_CHUNK
        blk = c0 // MOBA_BLOCK
        qc = lax.dynamic_slice_in_dim(q, c0, MOBA_Q_CHUNK, axis=2).astype(jnp.float32)
        tq = c0 + jnp.arange(MOBA_Q_CHUNK)
        k_own = lax.dynamic_index_in_dim(kp, blk, axis=2, keepdims=False).astype(jnp.float32)
        v_own = lax.dynamic_index_in_dim(vp, blk, axis=2, keepdims=False).astype(jnp.float32)
        kpos = blk * MOBA_BLOCK + jnp.arange(MOBA_BLOCK)
        l_own = jnp.einsum('bhqd,bhld->bhql', qc, k_own) * scale
        l_own = jnp.where(kpos[None, :] <= tq[:, None], l_own, NEG_INF)
        if n_sel == 0:
            p_own = jax.nn.softmax(l_own, axis=-1)
            out = jnp.einsum('bhql,bhld->bhqd', p_own, v_own)
            return out.astype(q.dtype)
        gate = jnp.einsum('bhqd,bhnd->bhqn', qc, kmean)
        gate = jnp.where(jnp.arange(nb) < blk, gate, NEG_INF)
        _, idx = lax.top_k(gate, n_sel)
        sel_ok = idx < blk
        k_sel = kp[b_idx, h_idx, idx].astype(jnp.float32)
        v_sel = vp[b_idx, h_idx, idx].astype(jnp.float32)
        l_sel = jnp.einsum('bhqd,bhqnld->bhqnl', qc, k_sel) * scale
        l_sel = jnp.where(sel_ok[..., None], l_sel, NEG_INF)
        l_sel = l_sel.reshape(B, H, MOBA_Q_CHUNK, n_sel * MOBA_BLOCK)
        p = jax.nn.softmax(jnp.concatenate([l_sel, l_own], axis=-1), axis=-1)
        p_sel = p[..., : n_sel * MOBA_BLOCK].reshape(B, H, MOBA_Q_CHUNK, n_sel, MOBA_BLOCK)
        p_own = p[..., n_sel * MOBA_BLOCK:]
        out = (jnp.einsum('bhqnl,bhqnld->bhqd', p_sel, v_sel)
               + jnp.einsum('bhql,bhld->bhqd', p_own, v_own))
        return out.astype(q.dtype)

    outs = lax.map(chunk, jnp.arange(S // MOBA_Q_CHUNK))
    return outs.transpose(1, 2, 0, 3, 4).reshape(B, H, S, hd)


def stick_breaking_attention(q, k, v):
    B, H, S, hd = q.shape
    kf = k.astype(jnp.float32)
    vf = v.astype(jnp.float32)
    s_pos = jnp.arange(S)
    scale = hd ** -0.5

    def block(bi):
        t0 = bi * SB_Q_BLOCK
        qb = lax.dynamic_slice_in_dim(q, t0, SB_Q_BLOCK, axis=2).astype(jnp.float32)
        tq = t0 + jnp.arange(SB_Q_BLOCK)
        z = jnp.einsum('bhqd,bhsd->bhqs', qb, kf) * scale
        strict = s_pos[None, :] < tq[:, None]
        log_keep = jnp.where(strict, jax.nn.log_sigmoid(-z), 0.0)
        after = lax.cumsum(log_keep, axis=3, reverse=True) - log_keep
        a = jnp.where(strict, jnp.exp(jax.nn.log_sigmoid(z) + after), 0.0)
        return jnp.einsum('bhqs,bhsd->bhqd', a, vf).astype(q.dtype)

    outs = lax.map(block, jnp.arange(S // SB_Q_BLOCK))
    return outs.transpose(1, 2, 0, 3, 4).reshape(B, H, S, hd)


def multiscale_pool(u, w_pool, pool_scale):
    B, S, _ = u.shape
    uf = u.astype(jnp.float32).reshape(B, S, N_POOL_GROUPS, POOL_GROUP_DIM)
    cs = jnp.concatenate([jnp.zeros((B, 1, N_POOL_GROUPS, POOL_GROUP_DIM), jnp.float32),
                          jnp.cumsum(uf, axis=1)], axis=1)
    t = jnp.arange(S)[:, None]
    win = jnp.array(POOL_WINDOWS, dtype=jnp.int32)[None, :]
    lo = jnp.maximum(t + 1 - win, 0)
    g_idx = jnp.arange(N_POOL_GROUPS)[None, :]
    win_sum = cs[:, 1:] - cs[:, lo, g_idx]
    count = (t + 1 - lo).astype(jnp.float32)
    d = win_sum / count[None, :, :, None] - uf
    y = jnp.einsum('bsgc,gcd->bsgd', d, w_pool.astype(jnp.float32))
    y = y.reshape(B, S, GROUP_WIDTH) * pool_scale.astype(jnp.float32)
    return y.astype(u.dtype)


def dilated_attention(q, k, v):
    B, H, S, hd = q.shape
    scale = hd ** -0.5

    def chunk(ci):
        t0 = ci * DIL_Q_CHUNK
        qc = lax.dynamic_slice_in_dim(q, t0, DIL_Q_CHUNK, axis=2).astype(jnp.float32)
        tq = t0 + jnp.arange(DIL_Q_CHUNK)
        lses = []
        outs = []
        for window, dil in DILATED_PATTERNS:
            m = jnp.arange(window // dil + 1)
            pos = tq[:, None] - dil * m[None, :]
            ok = pos >= 0
            posc = jnp.maximum(pos, 0)
            kg = k[:, :, posc].astype(jnp.float32)
            vg = v[:, :, posc].astype(jnp.float32)
            logits = jnp.einsum('bhqd,bhqkd->bhqk', qc, kg) * scale
            logits = jnp.where(ok, logits, NEG_INF)
            lse = jax.nn.logsumexp(logits, axis=-1)
            p = jnp.exp(logits - lse[..., None])
            outs.append(jnp.einsum('bhqk,bhqkd->bhqd', p, vg))
            lses.append(lse)
        alpha = jax.nn.softmax(jnp.stack(lses, axis=0), axis=0)
        out = jnp.einsum('pbhq,pbhqd->bhqd', alpha, jnp.stack(outs, axis=0))
        return out.astype(q.dtype)

    outs = lax.map(chunk, jnp.arange(S // DIL_Q_CHUNK))
    return outs.transpose(1, 2, 0, 3, 4).reshape(B, H, S, hd)


def hybrid_mixer(h, w_in, w_pool, pool_scale, mix_out_norm, w_out):
    B, S, _ = h.shape
    proj = h @ w_in
    parts = jnp.split(proj, [GROUP_WIDTH * i for i in range(1, 10)], axis=-1)
    qa, ka, va, qb, kb, vb, qd, kd, vd, u = parts

    def to_heads(t):
        return t.reshape(B, S, N_HEADS, HEAD_DIM).transpose(0, 2, 1, 3)

    def from_heads(t):
        return t.transpose(0, 2, 1, 3).reshape(B, S, GROUP_WIDTH)

    y_a = from_heads(moba_attention(to_heads(qa), to_heads(ka), to_heads(va)))
    y_b = from_heads(stick_breaking_attention(to_heads(qb), to_heads(kb), to_heads(vb)))
    y_c = multiscale_pool(u, w_pool, pool_scale)
    y_d = from_heads(dilated_attention(to_heads(qd), to_heads(kd), to_heads(vd)))
    y = jnp.stack([y_a, y_b, y_c, y_d], axis=2)
    y = rms_norm(y, mix_out_norm.reshape(N_MIXERS, GROUP_WIDTH)).reshape(B, S, MIX_WIDTH)
    return y @ w_out


def swiglu(h, w_gate, w_up, w_down):
    return (jax.nn.silu(h @ w_gate) * (h @ w_up)) @ w_down


def setup_inputs(seed: int = 0) -> dict:
    key = jax.random.key(seed)
    ks = jax.random.split(key, 13)
    f32 = jnp.float32

    def gain(k, n):
        return 1.0 + 0.05 * jax.random.normal(k, (DEPTH, n), f32)

    x = jax.random.normal(ks[0], (BATCH, SEQ, D_MODEL), f32)
    ln_mix_pre = gain(ks[1], D_MODEL)
    w_in = jax.random.normal(ks[2], (DEPTH, D_MODEL, IN_WIDTH), f32) * D_MODEL ** -0.5
    w_pool = jax.random.normal(ks[3], (DEPTH, N_POOL_GROUPS, POOL_GROUP_DIM, POOL_GROUP_DIM), f32) * POOL_GROUP_DIM ** -0.5
    pool_scale = 1.0 + 0.1 * jax.random.normal(ks[4], (DEPTH, GROUP_WIDTH), f32)
    mix_out_norm = gain(ks[5], MIX_WIDTH)
    w_out = jax.random.normal(ks[6], (DEPTH, MIX_WIDTH, D_MODEL), f32) * MIX_WIDTH ** -0.5
    ln_mix_post = gain(ks[7], D_MODEL)
    ln_ffn_pre = gain(ks[8], D_MODEL)
    w_gate = jax.random.normal(ks[9], (DEPTH, D_MODEL, D_FF), f32) * D_MODEL ** -0.5
    w_up = jax.random.normal(ks[10], (DEPTH, D_MODEL, D_FF), f32) * D_MODEL ** -0.5
    w_down = jax.random.normal(ks[11], (DEPTH, D_FF, D_MODEL), f32) * D_FF ** -0.5
    ln_ffn_post = gain(ks[12], D_MODEL)
    return {"x": x, "ln_mix_pre": ln_mix_pre, "w_in": w_in, "w_pool": w_pool,
            "pool_scale": pool_scale, "mix_out_norm": mix_out_norm, "w_out": w_out,
            "ln_mix_post": ln_mix_post, "ln_ffn_pre": ln_ffn_pre, "w_gate": w_gate,
            "w_up": w_up, "w_down": w_down, "ln_ffn_post": ln_ffn_post}


def reference(x, ln_mix_pre, w_in, w_pool, pool_scale, mix_out_norm, w_out,
              ln_mix_post, ln_ffn_pre, w_gate, w_up, w_down, ln_ffn_post):
    for l in range(DEPTH):
        h = rms_norm(x, ln_mix_pre[l])
        m = hybrid_mixer(h, w_in[l], w_pool[l], pool_scale[l], mix_out_norm[l], w_out[l])
        x = x + rms_norm(m, ln_mix_post[l])
        h = rms_norm(x, ln_ffn_pre[l])
        f = swiglu(h, w_gate[l], w_up[l], w_down[l])
        x = x + rms_norm(f, ln_ffn_post[l])
    return x
```

```cpp
#include <hip/hip_runtime.h>
#include <cstdio>
#include <cstdint>
#ifndef MK_N_LAUNCHES
#define MK_N_LAUNCHES 1
#endif
namespace pg8 {
#define PG8_LAS __attribute__((address_space(3)))
typedef unsigned short bf16_t;
typedef short bf16x8 __attribute__((ext_vector_type(8)));
typedef float f32x4 __attribute__((ext_vector_type(4)));
typedef unsigned u32x4 __attribute__((ext_vector_type(4)));
typedef int i32x4 __attribute__((ext_vector_type(4)));
typedef int i32x8 __attribute__((ext_vector_type(8)));
constexpr int BM = 256, BK = 64, HALF = 128, HTB = HALF * BK * 2  , STAGE_BYTES = 8 * HTB, NXCD = 8, WGM = 8;

__host__ __device__ __forceinline__ int lds_byte(int r, int c) { const int st = (r >> 4) * 2 + (c >> 5), rr = r & 15, cc = c & 31, ob = rr * 64 + cc * 2; return st * 1024 + (ob ^ (((ob >> 9) & 1) << 5)); }
__host__ __device__ __forceinline__ void stage_rc(int b, int& R, int& C) { const int st = b / 1024, sb = b % 1024, swz = sb ^ (((sb >> 9) & 1) << 5); R = (st >> 1) * 16 + swz / 64; C = (st & 1) * 32 + (swz % 64) / 2; }
__host__ __device__ __forceinline__ int perm32(int rho) { const int n = rho >> 4, i = rho & 15; return 8 * (i >> 2) + 4 * n + (i & 3); }

struct Unit { int pm, pn; };
struct Gemm { const bf16_t* A; const bf16_t* Bt; int M, N, K; };

struct StaticOrder {
    int nM, nN, nwg, G, c;
    __host__ __device__ void init(int M, int N, int G_, int c_) { nM = M / BM; nN = N / BM; nwg = nM * nN; G = G_; c = c_; }
    __host__ __device__ bool next(int i, Unit& u) const {
        const long L = (long)i * G + c; if (L >= nwg) return false;
        int wgid = (int)L; { const int q = nwg / NXCD, r = nwg % NXCD, xcd = wgid % NXCD, off = wgid / NXCD; wgid = (xcd < r ? xcd * (q + 1) : r * (q + 1) + (xcd - r) * q) + off; }
        const int nig = WGM * nN, gid = wgid / nig, fm = gid * WGM, gsz = (nM - fm) < WGM ? (nM - fm) : WGM;
        u.pm = fm + ((wgid % nig) % gsz); u.pn = (wgid % nig) / gsz; return true;
    }
    __device__ __forceinline__ void a_ready(const Unit&) const {}
    __device__ __forceinline__ void done(const Unit&) const {}
};

typedef unsigned u32x2 __attribute__((ext_vector_type(2)));
typedef float f32x2_cv __attribute__((ext_vector_type(2))); typedef __bf16 bf16x2_cv __attribute__((ext_vector_type(2)));
__device__ __forceinline__ unsigned cvt_pk_bf16(float lo, float hi) { const f32x2_cv v = {lo, hi}; return __builtin_bit_cast(unsigned, __builtin_convertvector(v, bf16x2_cv)); }

__device__ __forceinline__ float ld_f32_asm(const float* p) { float r; asm volatile("global_load_dword %0, %1, off" : "=&v"(r) : "v"(p) : "memory"); return r; }
__device__ __forceinline__ f32x4 ld_f32x4_asm(const float* p) { f32x4 r; asm volatile("global_load_dwordx4 %0, %1, off" : "=&v"(r) : "v"(p) : "memory"); return r; }
#define PG8_WAIT_SCALES(c0, c1, c2, c3, rsv) asm volatile("s_waitcnt vmcnt(0)" : "+v"(c0), "+v"(c1), "+v"(c2), "+v"(c3), "+v"(rsv[0][0]), "+v"(rsv[0][1]), "+v"(rsv[0][2]), "+v"(rsv[0][3]), "+v"(rsv[1][0]), "+v"(rsv[1][1]), "+v"(rsv[1][2]), "+v"(rsv[1][3]) :: "memory")
__device__ __forceinline__ void st16_wt(void* p, u32x4 w) { asm volatile("global_store_dwordx4 %0, %1, off sc1\n\ts_nop 1" :: "v"(p), "v"(w) : "memory"); }
struct EpiProj {
    static constexpr bool PERM = true, AFTER_DRAIN = false;
    bf16_t* O; int ldc; float* ksum;
    __device__ __forceinline__ void operator()(const f32x4 (&acc)[2][2][4][2], const Unit& u, int wr, int wc, int fr, int fq) const {
        const int row0 = u.pm * BM + wr * 64 + fr, col0 = u.pn * BM + wc * 32 + 8 * fq;
#pragma unroll
        for (int ai = 0; ai < 2; ++ai)
#pragma unroll
            for (int m = 0; m < 4; ++m) { bf16_t* rowp = O + (size_t)(row0 + ai * HALF + m * 16) * ldc + col0;
#pragma unroll
                for (int bj = 0; bj < 2; ++bj) { const f32x4 v0 = acc[ai][bj][m][0], v1 = acc[ai][bj][m][1];
                    u32x4 w; w.x = cvt_pk_bf16(v0[0], v0[1]); w.y = cvt_pk_bf16(v0[2], v0[3]); w.z = cvt_pk_bf16(v1[0], v1[1]); w.w = cvt_pk_bf16(v1[2], v1[3]);
                    st16_wt(rowp + bj * HALF, w); } }
        if (u.pn >= 4 && u.pn < 8) {
#pragma unroll
            for (int bj = 0; bj < 2; ++bj)
#pragma unroll
                for (int n = 0; n < 2; ++n) { f32x4 s = (f32x4){0.f, 0.f, 0.f, 0.f};
#pragma unroll
                    for (int ai = 0; ai < 2; ++ai)
#pragma unroll
                        for (int m = 0; m < 4; ++m) s += acc[ai][bj][m][n];
#pragma unroll
                    for (int o = 1; o < 16; o <<= 1) { s[0] += __shfl_xor(s[0], o); s[1] += __shfl_xor(s[1], o); s[2] += __shfl_xor(s[2], o); s[3] += __shfl_xor(s[3], o); }
                    if (fr == 0) { float* kp = ksum + (size_t)u.pm * 1024 + (u.pn - 4) * BM + bj * HALF + wc * 32 + 8 * fq + 4 * n;
#pragma unroll
                        for (int j = 0; j < 4; ++j) (void)__hip_atomic_fetch_add(kp + j, s[j], __ATOMIC_RELAXED, __HIP_MEMORY_SCOPE_AGENT); } }
        }
    }
};
struct EpiF32 {
    static constexpr bool PERM = false, AFTER_DRAIN = false;
    float* C; int ldc;
    __device__ __forceinline__ void operator()(const f32x4 (&acc)[2][2][4][2], const Unit& u, int wr, int wc, int fr, int fq) const {
        const int row0 = u.pm * BM + wr * 64 + fr, col0 = u.pn * BM + wc * 32 + 4 * fq;
#pragma unroll
        for (int ai = 0; ai < 2; ++ai)
#pragma unroll
            for (int m = 0; m < 4; ++m) { float* rowp = C + (size_t)(row0 + ai * HALF + m * 16) * ldc + col0;
#pragma unroll
                for (int bj = 0; bj < 2; ++bj)
#pragma unroll
                    for (int n = 0; n < 2; ++n) *(f32x4*)(rowp + bj * HALF + n * 16) = acc[ai][bj][m][n]; }
    }
};
struct EpiSwiGLU {
    static constexpr bool PERM = true, AFTER_DRAIN = false;
    bf16_t* O; int ldc;
    static __device__ __forceinline__ float silu_mul(float g, float up) { return g * up * __builtin_amdgcn_rcpf(1.0f + __builtin_amdgcn_exp2f(g * -1.4426950408889634f)); }
    __device__ __forceinline__ void operator()(const f32x4 (&acc)[2][2][4][2], const Unit& u, int wr, int wc, int fr, int fq) const {
        const int row0 = u.pm * BM + wr * 64 + fr, col0 = u.pn * HALF + wc * 32 + 8 * fq;
#pragma unroll
        for (int ai = 0; ai < 2; ++ai)
#pragma unroll
            for (int m = 0; m < 4; ++m) { bf16_t* rowp = O + (size_t)(row0 + ai * HALF + m * 16) * ldc + col0;
                const f32x4 g0 = acc[ai][0][m][0], g1 = acc[ai][0][m][1], u0 = acc[ai][1][m][0], u1 = acc[ai][1][m][1];
                u32x4 w; w.x = cvt_pk_bf16(silu_mul(g0[0], u0[0]), silu_mul(g0[1], u0[1])); w.y = cvt_pk_bf16(silu_mul(g0[2], u0[2]), silu_mul(g0[3], u0[3]));
                w.z = cvt_pk_bf16(silu_mul(g1[0], u1[0]), silu_mul(g1[1], u1[1])); w.w = cvt_pk_bf16(silu_mul(g1[2], u1[2]), silu_mul(g1[3], u1[3]));
                st16_wt(rowp, w); }
    }
};
struct EpiSwiGLU8 {
    static constexpr bool PERM = true, AFTER_DRAIN = false;
    unsigned char* O; int ldc; const float* rs; const float* cs;
    __device__ __forceinline__ void operator()(const f32x4 (&acc)[2][2][4][2], const Unit& u, int wr, int wc, int fr, int fq) const {
        const int row0 = u.pm * BM + wr * 64 + fr, col0 = u.pn * HALF + wc * 32 + 8 * fq;
        const float* csp = cs + (size_t)u.pn * BM + wc * 32 + 8 * fq;
        f32x4 cg0 = ld_f32x4_asm(csp), cg1 = ld_f32x4_asm(csp + 4), cu0 = ld_f32x4_asm(csp + HALF), cu1 = ld_f32x4_asm(csp + HALF + 4);
        float rsv[2][4];
#pragma unroll
        for (int ai = 0; ai < 2; ++ai)
#pragma unroll
            for (int m = 0; m < 4; ++m) rsv[ai][m] = ld_f32_asm(rs + row0 + ai * HALF + m * 16);
        PG8_WAIT_SCALES(cg0, cg1, cu0, cu1, rsv);
#pragma unroll
        for (int ai = 0; ai < 2; ++ai)
#pragma unroll
            for (int m = 0; m < 4; ++m) { const int row = row0 + ai * HALF + m * 16; unsigned char* rowp = O + (size_t)row * ldc + col0; const float r = rsv[ai][m];
                const i32x4 ig0 = __builtin_bit_cast(i32x4, acc[ai][0][m][0]), ig1 = __builtin_bit_cast(i32x4, acc[ai][0][m][1]), iu0 = __builtin_bit_cast(i32x4, acc[ai][1][m][0]), iu1 = __builtin_bit_cast(i32x4, acc[ai][1][m][1]);
                f32x4 g0, g1, u0, u1;
#pragma unroll
                for (int j = 0; j < 4; ++j) { g0[j] = (float)ig0[j] * (r * cg0[j]); g1[j] = (float)ig1[j] * (r * cg1[j]); u0[j] = (float)iu0[j] * (r * cu0[j]); u1[j] = (float)iu1[j] * (r * cu1[j]); }
                int w0 = 0, w1 = 0;
                w0 = __builtin_amdgcn_cvt_pk_fp8_f32(EpiSwiGLU::silu_mul(g0[0], u0[0]), EpiSwiGLU::silu_mul(g0[1], u0[1]), w0, false); w0 = __builtin_amdgcn_cvt_pk_fp8_f32(EpiSwiGLU::silu_mul(g0[2], u0[2]), EpiSwiGLU::silu_mul(g0[3], u0[3]), w0, true);
                w1 = __builtin_amdgcn_cvt_pk_fp8_f32(EpiSwiGLU::silu_mul(g1[0], u1[0]), EpiSwiGLU::silu_mul(g1[1], u1[1]), w1, false); w1 = __builtin_amdgcn_cvt_pk_fp8_f32(EpiSwiGLU::silu_mul(g1[2], u1[2]), EpiSwiGLU::silu_mul(g1[3], u1[3]), w1, true);
                u32x2 w; w.x = (unsigned)w0; w.y = (unsigned)w1; *(u32x2*)rowp = w; }
    }
};
struct EpiProj8 {
    static constexpr bool PERM = true, AFTER_DRAIN = false;
    bf16_t* O; int ldc; int coff; const float* rs; const float* cs;
    __device__ __forceinline__ void operator()(const f32x4 (&acc)[2][2][4][2], const Unit& u, int wr, int wc, int fr, int fq) const {
        const int row0 = u.pm * BM + wr * 64 + fr, col0 = u.pn * BM + wc * 32 + 8 * fq;
        const float* csp = cs + col0;
        f32x4 c00 = ld_f32x4_asm(csp), c01 = ld_f32x4_asm(csp + 4), c10 = ld_f32x4_asm(csp + HALF), c11 = ld_f32x4_asm(csp + HALF + 4);
        float rsv[2][4];
#pragma unroll
        for (int ai = 0; ai < 2; ++ai)
#pragma unroll
            for (int m = 0; m < 4; ++m) rsv[ai][m] = ld_f32_asm(rs + row0 + ai * HALF + m * 16);
        PG8_WAIT_SCALES(c00, c01, c10, c11, rsv);
#pragma unroll
        for (int ai = 0; ai < 2; ++ai)
#pragma unroll
            for (int m = 0; m < 4; ++m) { const int row = row0 + ai * HALF + m * 16; bf16_t* rowp = O + (size_t)row * ldc + coff + col0; const float r = rsv[ai][m];
#pragma unroll
                for (int bj = 0; bj < 2; ++bj) { const i32x4 i0 = __builtin_bit_cast(i32x4, acc[ai][bj][m][0]), i1 = __builtin_bit_cast(i32x4, acc[ai][bj][m][1]);
                    const f32x4 ca = bj ? c10 : c00, cb = bj ? c11 : c01; f32x4 v0, v1;
#pragma unroll
                    for (int j = 0; j < 4; ++j) { v0[j] = (float)i0[j] * (r * ca[j]); v1[j] = (float)i1[j] * (r * cb[j]); }
                    u32x4 w; w.x = cvt_pk_bf16(v0[0], v0[1]); w.y = cvt_pk_bf16(v0[2], v0[3]); w.z = cvt_pk_bf16(v1[0], v1[1]); w.w = cvt_pk_bf16(v1[2], v1[3]);
                    st16_wt(rowp + bj * HALF, w); } }
    }
};
struct EpiF32S {
    static constexpr bool PERM = true, AFTER_DRAIN = false;
    bf16_t* C; int ldc; const float* rs; const float* cs;
    __device__ __forceinline__ void operator()(const f32x4 (&acc)[2][2][4][2], const Unit& u, int wr, int wc, int fr, int fq) const {
        const int row0 = u.pm * BM + wr * 64 + fr, col0 = u.pn * BM + wc * 32 + 8 * fq;
        f32x4 cv[2][2];
#pragma unroll
        for (int bj = 0; bj < 2; ++bj)
#pragma unroll
            for (int n = 0; n < 2; ++n) cv[bj][n] = ld_f32x4_asm(cs + col0 + bj * HALF + n * 4);
        float rsv[2][4];
#pragma unroll
        for (int ai = 0; ai < 2; ++ai)
#pragma unroll
            for (int m = 0; m < 4; ++m) rsv[ai][m] = ld_f32_asm(rs + row0 + ai * HALF + m * 16);
        PG8_WAIT_SCALES(cv[0][0], cv[0][1], cv[1][0], cv[1][1], rsv);
#pragma unroll
        for (int ai = 0; ai < 2; ++ai)
#pragma unroll
            for (int m = 0; m < 4; ++m) { const int row = row0 + ai * HALF + m * 16; bf16_t* rowp = C + (size_t)row * ldc + col0; const float r = rsv[ai][m];
#pragma unroll
                for (int bj = 0; bj < 2; ++bj) { const i32x4 i0 = __builtin_bit_cast(i32x4, acc[ai][bj][m][0]), i1 = __builtin_bit_cast(i32x4, acc[ai][bj][m][1]); f32x4 v0, v1;
#pragma unroll
                    for (int j = 0; j < 4; ++j) { v0[j] = (float)i0[j] * (r * cv[bj][0][j]); v1[j] = (float)i1[j] * (r * cv[bj][1][j]); }
                    u32x4 w; w.x = cvt_pk_bf16(v0[0], v0[1]); w.y = cvt_pk_bf16(v0[2], v0[3]); w.z = cvt_pk_bf16(v1[0], v1[1]); w.w = cvt_pk_bf16(v1[2], v1[3]);
                    st16_wt(rowp + bj * HALF, w); } }
    }
};
struct EpiF32C {
    static constexpr bool PERM = true, AFTER_DRAIN = false;
    bf16_t* C; int ldc; const float* cs;
    __device__ __forceinline__ void operator()(const f32x4 (&acc)[2][2][4][2], const Unit& u, int wr, int wc, int fr, int fq) const {
        const int row0 = u.pm * BM + wr * 64 + fr, col0 = u.pn * BM + wc * 32 + 8 * fq;
        f32x4 cv[2][2];
#pragma unroll
        for (int bj = 0; bj < 2; ++bj)
#pragma unroll
            for (int n = 0; n < 2; ++n) cv[bj][n] = ld_f32x4_asm(cs + col0 + bj * HALF + n * 4);
        asm volatile("s_waitcnt vmcnt(0)" : "+v"(cv[0][0]), "+v"(cv[0][1]), "+v"(cv[1][0]), "+v"(cv[1][1]) :: "memory");
#pragma unroll
        for (int bj = 0; bj < 2; ++bj)
#pragma unroll
            for (int n = 0; n < 2; ++n) cv[bj][n] *= (1.0f / 448.0f);
#pragma unroll
        for (int ai = 0; ai < 2; ++ai)
#pragma unroll
            for (int m = 0; m < 4; ++m) { bf16_t* rowp = C + (size_t)(row0 + ai * HALF + m * 16) * ldc + col0;
#pragma unroll
                for (int bj = 0; bj < 2; ++bj) { const f32x4 v0 = acc[ai][bj][m][0] * cv[bj][0], v1 = acc[ai][bj][m][1] * cv[bj][1];
                    u32x4 w; w.x = cvt_pk_bf16(v0[0], v0[1]); w.y = cvt_pk_bf16(v0[2], v0[3]); w.z = cvt_pk_bf16(v1[0], v1[1]); w.w = cvt_pk_bf16(v1[2], v1[3]);
                    st16_wt(rowp + bj * HALF, w); } }
    }
};

template <class Epi, class Sched, bool ALIGN_EPI = false, bool SP2 = false, int DT = 0>
__device__ __forceinline__ void gemm_phase(PG8_LAS unsigned char* lds, const Gemm g, const Sched& S, const Epi& E) {
    int tid = threadIdx.x; asm volatile("" : "+v"(tid));
    const int wid = __builtin_amdgcn_readfirstlane(tid >> 6), lane = tid & 63, wr = wid >> 2, wc = wid & 3, fr = lane & 15, fq = lane >> 4;
    const int K = g.K, nt = K / BK;
    unsigned voffA[2], voffB[2];
#pragma unroll
    for (int i = 0; i < 2; ++i) { int R, C; stage_rc(tid * 16 + i * 8192, R, C); const int Rb = Epi::PERM ? ((R & ~31) + perm32(R & 31)) : R;
        voffA[i] = (unsigned)(R * K + C) * 2u; voffB[i] = (unsigned)(Rb * K + C) * 2u; }
    const size_t kstep = (size_t)(BK * 2);
    const size_t hstep = (size_t)HALF * K * 2;
    const size_t tstep = 2 * hstep;
    const unsigned ldsw = (unsigned)wid * 1024u;
    const int aoff = lds_byte(wr * 64 + fr, fq * 8), boff = lds_byte(wc * 32 + fr, fq * 8);
#define PG8_SA(b, h) (((b) * 2 + (h)) * HTB)
#define PG8_SB(b, h) ((4 + (b) * 2 + (h)) * HTB)
#define PG8_STAGE(bufoff, gbase, voff) do { _Pragma("unroll") for (int _i = 0; _i < 2; ++_i) \
        __builtin_amdgcn_global_load_lds((const unsigned*)((const char*)(gbase) + (voff)[_i]), (PG8_LAS unsigned*)(lds + (bufoff) + ldsw + _i * 8192), 16, 0, 0); } while (0)
#define PG8_LDA(dst, b, h) do { _Pragma("unroll") for (int m = 0; m < 4; ++m) _Pragma("unroll") for (int k = 0; k < 2; ++k) dst[m][k] = *(const PG8_LAS bf16x8*)(lds + PG8_SA(b, h) + aoff + m * 2048 + k * 1024); } while (0)
#define PG8_LDB(dst, b, h) do { _Pragma("unroll") for (int n = 0; n < 2; ++n) _Pragma("unroll") for (int k = 0; k < 2; ++k) dst[n][k] = *(const PG8_LAS bf16x8*)(lds + PG8_SB(b, h) + boff + n * 2048 + k * 1024); } while (0)
#define PG8_MMA(ai, bj, At, Bt) do { __builtin_amdgcn_s_setprio(1); _Pragma("unroll") for (int m = 0; m < 4; ++m) _Pragma("unroll") for (int n = 0; n < 2; ++n) { \
        if constexpr (DT == 2) { const i32x4 b0_ = __builtin_bit_cast(i32x4, Bt[n][0]), b1_ = __builtin_bit_cast(i32x4, Bt[n][1]), a0_ = __builtin_bit_cast(i32x4, At[m][0]), a1_ = __builtin_bit_cast(i32x4, At[m][1]); \
            const i32x8 b8_ = (i32x8){b0_[0], b0_[1], b0_[2], b0_[3], b1_[0], b1_[1], b1_[2], b1_[3]}, a8_ = (i32x8){a0_[0], a0_[1], a0_[2], a0_[3], a1_[0], a1_[1], a1_[2], a1_[3]}; \
            asm volatile("v_mfma_scale_f32_16x16x128_f8f6f4 %0, %1, %2, %0, %3, %3 op_sel_hi:[0,0,0]" : "+v"(acc[ai][bj][m][n]) : "v"(b8_), "v"(a8_), "v"(f8scale)); } \
        else { _Pragma("unroll") for (int k = 0; k < 2; ++k) { \
        if constexpr (DT == 1) acc[ai][bj][m][n] = __builtin_bit_cast(f32x4, __builtin_amdgcn_mfma_i32_16x16x64_i8(__builtin_bit_cast(i32x4, Bt[n][k]), __builtin_bit_cast(i32x4, At[m][k]), __builtin_bit_cast(i32x4, acc[ai][bj][m][n]), 0, 0, 0)); \
        else acc[ai][bj][m][n] = __builtin_amdgcn_mfma_f32_16x16x32_bf16(Bt[n][k], At[m][k], acc[ai][bj][m][n], 0, 0, 0); } } } __builtin_amdgcn_s_setprio(0); } while (0)
#define PG8_WAIT_V(n) asm volatile("s_waitcnt vmcnt(" #n ")" ::: "memory")
#define PG8_WAIT_L(n) asm volatile("s_waitcnt lgkmcnt(" #n ")" ::: "memory")
#define PG8_BAR __builtin_amdgcn_s_barrier()
#define PG8_SCHED __builtin_amdgcn_sched_barrier(0)
    const int f8scale = 0x7f7f7f7f;
    Unit cur, nxt; int ui = 0;
    if (!S.next(0, cur)) return;
    f32x4 acc[2][2][4][2];
#pragma unroll
    for (int a = 0; a < 2; ++a)
#pragma unroll
        for (int b = 0; b < 2; ++b)
#pragma unroll
            for (int m = 0; m < 4; ++m)
#pragma unroll
                for (int n = 0; n < 2; ++n) acc[a][b][m][n] = (f32x4){0.f, 0.f, 0.f, 0.f};
    bf16x8 At[4][2], B0[2][2], B1[2][2];
    const char* cA = (const char*)g.A + (size_t)cur.pm * tstep; const char* cB = (const char*)g.Bt + (size_t)cur.pn * tstep;
    S.a_ready(cur);
    if constexpr (SP2) {
        PG8_STAGE(PG8_SB(0, 0), cB, voffB); PG8_STAGE(PG8_SB(0, 1), cB + hstep, voffB); PG8_STAGE(PG8_SA(0, 0), cA, voffA); PG8_STAGE(PG8_SA(0, 1), cA + hstep, voffA);
        if (wr == 1) PG8_BAR;
        PG8_WAIT_V(2); PG8_BAR;
        PG8_STAGE(PG8_SB(1, 0), cB + kstep, voffB); PG8_STAGE(PG8_SA(1, 0), cA + kstep, voffA); PG8_STAGE(PG8_SB(1, 1), cB + hstep + kstep, voffB);
        PG8_WAIT_V(6); PG8_BAR;
    } else {
        PG8_STAGE(PG8_SB(0, 0), cB, voffB); PG8_STAGE(PG8_SA(0, 0), cA, voffA); PG8_STAGE(PG8_SB(0, 1), cB + hstep, voffB); PG8_STAGE(PG8_SA(0, 1), cA + hstep, voffA);
        if (wr == 1) PG8_BAR;
        PG8_WAIT_V(4); PG8_BAR;
        PG8_STAGE(PG8_SB(1, 0), cB + kstep, voffB); PG8_STAGE(PG8_SA(1, 0), cA + kstep, voffA); PG8_STAGE(PG8_SB(1, 1), cB + hstep + kstep, voffB);
        PG8_WAIT_V(6); PG8_BAR;
    }
    for (;;) {
        const bool has_next = S.next(ui + 1, nxt);
        const char* nA = has_next ? (const char*)g.A + (size_t)nxt.pm * tstep : cA; const char* nB = has_next ? (const char*)g.Bt + (size_t)nxt.pn * tstep : cB;
        for (int t = 0; t < nt; t += 2) {
            const bool last = (t == nt - 2);
            const char* a1 = cA + (size_t)(t + 1) * kstep;
            const char* a2 = last ? nA : cA + (size_t)(t + 2) * kstep; const char* b2 = last ? nB : cB + (size_t)(t + 2) * kstep;
            const char* a3 = a2 + kstep; const char* b3 = b2 + kstep;
            if (last && has_next) S.a_ready(nxt);
            if constexpr (SP2) {
            PG8_LDB(B0, 0, 0); PG8_LDB(B1, 0, 1); PG8_SCHED; PG8_LDA(At, 0, 0); PG8_STAGE(PG8_SA(1, 1), a1 + hstep, voffA);
            PG8_WAIT_V(8); PG8_WAIT_L(0); PG8_BAR; PG8_MMA(0, 0, At, B0); PG8_MMA(0, 1, At, B1); PG8_BAR; PG8_SCHED;
            PG8_LDA(At, 0, 1); PG8_STAGE(PG8_SB(0, 0), b2, voffB); PG8_STAGE(PG8_SB(0, 1), b2 + hstep, voffB); PG8_STAGE(PG8_SA(0, 0), a2, voffA);
            PG8_WAIT_V(8); PG8_WAIT_L(0); PG8_BAR; PG8_MMA(1, 0, At, B0); PG8_MMA(1, 1, At, B1); PG8_BAR; PG8_SCHED;
            PG8_LDB(B0, 1, 0); PG8_LDB(B1, 1, 1); PG8_SCHED; PG8_LDA(At, 1, 0); PG8_STAGE(PG8_SA(0, 1), a2 + hstep, voffA);
            PG8_WAIT_V(8); PG8_WAIT_L(0); PG8_BAR; PG8_MMA(0, 0, At, B0); PG8_MMA(0, 1, At, B1); PG8_BAR; PG8_SCHED;
            PG8_LDA(At, 1, 1); PG8_STAGE(PG8_SB(1, 0), b3, voffB); PG8_STAGE(PG8_SB(1, 1), b3 + hstep, voffB); PG8_STAGE(PG8_SA(1, 0), a3, voffA);
            PG8_WAIT_V(8); PG8_WAIT_L(0); PG8_BAR; PG8_MMA(1, 0, At, B0); PG8_MMA(1, 1, At, B1); PG8_BAR; PG8_SCHED;
            } else {
            PG8_LDB(B0, 0, 0); PG8_SCHED; PG8_LDA(At, 0, 0); PG8_STAGE(PG8_SA(1, 1), a1 + hstep, voffA);
            PG8_WAIT_L(8); PG8_BAR; PG8_WAIT_L(0); PG8_MMA(0, 0, At, B0); PG8_BAR; PG8_SCHED;
            PG8_LDB(B1, 0, 1); PG8_STAGE(PG8_SB(0, 0), b2, voffB);
            PG8_BAR; PG8_WAIT_L(0); PG8_MMA(0, 1, At, B1); PG8_BAR;
            PG8_LDA(At, 0, 1); PG8_STAGE(PG8_SA(0, 0), a2, voffA);
            PG8_BAR; PG8_WAIT_L(0); PG8_MMA(1, 0, At, B0); PG8_BAR; PG8_SCHED;
            PG8_STAGE(PG8_SB(0, 1), b2 + hstep, voffB);
            PG8_WAIT_V(6); PG8_BAR; PG8_MMA(1, 1, At, B1); PG8_BAR;
            PG8_LDB(B0, 1, 0); PG8_SCHED; PG8_LDA(At, 1, 0); PG8_STAGE(PG8_SA(0, 1), a2 + hstep, voffA);
            PG8_WAIT_L(8); PG8_BAR; PG8_WAIT_L(0); PG8_MMA(0, 0, At, B0); PG8_BAR; PG8_SCHED;
            PG8_LDB(B1, 1, 1); PG8_STAGE(PG8_SB(1, 0), b3, voffB);
            PG8_BAR; PG8_WAIT_L(0); PG8_MMA(0, 1, At, B1); PG8_BAR;
            PG8_LDA(At, 1, 1); PG8_STAGE(PG8_SA(1, 0), a3, voffA);
            PG8_BAR; PG8_WAIT_L(0); PG8_MMA(1, 0, At, B0); PG8_BAR; PG8_SCHED;
            PG8_STAGE(PG8_SB(1, 1), b3 + hstep, voffB);
            PG8_WAIT_V(6); PG8_BAR; PG8_MMA(1, 1, At, B1); PG8_BAR;
            }
        }
        if constexpr (DT == 2) asm volatile("s_nop 15\n\ts_nop 15" ::: "memory");
        if constexpr (ALIGN_EPI) { if (wr == 0) PG8_BAR; }
        if constexpr (!Epi::AFTER_DRAIN) { E(acc, cur, wr, wc, fr, fq); S.done(cur); }
        if (!has_next) break;
#pragma unroll
        for (int a = 0; a < 2; ++a)
#pragma unroll
            for (int b = 0; b < 2; ++b)
#pragma unroll
                for (int m = 0; m < 4; ++m)
#pragma unroll
                    for (int n = 0; n < 2; ++n) acc[a][b][m][n] = (f32x4){0.f, 0.f, 0.f, 0.f};
        cur = nxt; cA = nA; cB = nB; ++ui;
        if constexpr (ALIGN_EPI) { if (wr == 1) PG8_BAR; }
    }
    PG8_WAIT_V(0);
    if constexpr (!ALIGN_EPI) { if (wr == 0) PG8_BAR; }
    PG8_BAR;
    if constexpr (Epi::AFTER_DRAIN) { E.fused(acc, cur, wr, wc, fr, fq, lds, wid, lane); S.done(cur); }
#undef PG8_SA
#undef PG8_SB
#undef PG8_STAGE
#undef PG8_LDA
#undef PG8_LDB
#undef PG8_MMA
#undef PG8_WAIT_V
#undef PG8_WAIT_L
#undef PG8_BAR
#undef PG8_SCHED
}
}

constexpr int BATCH = 4, SEQ = 2048, DM = 4096, DEPTH = 2, HD = 128, GW = 1024, NHEAD = 8, INW = 10240, DFF = 11008, NGU = 2 * DFF;
constexpr int M = BATCH * SEQ;
constexpr float RMS_EPS = 1e-6f;
constexpr int NWAVES = 8;

constexpr size_t MiB = 1u << 20;
constexpr size_t WS_CTL = 0, CTL_ZERO_BYTES = 2 * MiB;
constexpr size_t WS_CMAX = 1 * MiB + 512 * 1024;
constexpr size_t WS_CMAX_IN = WS_CMAX + 192 * 1024, WS_CMAX_OUT = WS_CMAX + 256 * 1024;
constexpr size_t WS_CMAX_DN = WS_CMAX + 320 * 1024;
constexpr size_t WS_KSUM = 1 * MiB;
constexpr size_t WS_W = 2 * MiB, W_LAYER = 370 * MiB;
constexpr size_t W_IN = 0  , W_IN8 = 16 * MiB  , W_OUT = 80 * MiB  , W_GU = 112 * MiB, W_DN = 284 * MiB  , W_DN_TMP = 198 * MiB  ;
constexpr size_t WS_WP = 742 * MiB;
constexpr size_t WS_HS = 1223 * MiB;
constexpr size_t WS_H = 743 * MiB;
constexpr size_t WS_PROJ = 807 * MiB;
constexpr size_t WS_Y = 967 * MiB;
constexpr size_t WS_ACT = WS_PROJ;
constexpr size_t WS_YN = 1031 * MiB;
constexpr size_t WS_MF = 1095 * MiB;
constexpr size_t WS_H8 = 1224 * MiB;
constexpr size_t WS_YS = WS_HS + 64 * 1024;
constexpr size_t WS_XS = 1428 * MiB;
constexpr size_t WS_END = 1492 * MiB;
constexpr size_t TMP_GU0 = 807 * MiB, TMP_IN0 = 979 * MiB, TMP_OUT0 = 1043 * MiB, TMP_IN1 = 1075 * MiB, TMP_OUT1 = 1139 * MiB, TMP_GU1 = 1256 * MiB;
static_assert(TMP_OUT1 + 32 * MiB <= WS_HS && TMP_GU1 + 172 * MiB <= WS_XS && WS_H8 + 32 * MiB <= TMP_GU1, "prologue temporaries");
static_assert((size_t)INW * DM * 2 == 80 * MiB && (size_t)DM * DM * 2 == 32 * MiB && (size_t)NGU * DM * 2 == 172 * MiB && (size_t)DM * DFF * 2 == 86 * MiB, "weight sizes");
static_assert((size_t)M * DFF * 2 <= WS_YN - WS_PROJ && (size_t)M * INW * 2 == 160 * MiB && (size_t)M * DM * 2 == 64 * MiB && (size_t)M * DM * 4 == 128 * MiB, "activation sizes");
constexpr int CW_TMO = 0, CW_BAR = 4096;

constexpr int RING_OFF = 0, RING_BYTES = 131072;
constexpr int LDSCTL_OFF = RING_BYTES, MISC_OFF = LDSCTL_OFF + 320;
constexpr int LDS_BYTES = 147456;
static_assert(MISC_OFF + 128 <= LDS_BYTES, "LDS map");

#define GAS __attribute__((address_space(1)))
#define LAS __attribute__((address_space(3)))
typedef unsigned short bf16;
typedef unsigned v4u __attribute__((ext_vector_type(4)));
typedef unsigned v2u __attribute__((ext_vector_type(2)));
typedef float f32x4 __attribute__((ext_vector_type(4)));
typedef float f32x16 __attribute__((ext_vector_type(16)));
typedef short bf16x8 __attribute__((ext_vector_type(8)));
typedef short s16x4 __attribute__((ext_vector_type(4)));
typedef GAS unsigned gu32;
#define RLX_AGENT __ATOMIC_RELAXED, __HIP_MEMORY_SCOPE_AGENT
#define LDS_WAIT() asm volatile("s_waitcnt lgkmcnt(0)" ::: "memory")
#define VM_WAIT() asm volatile("s_waitcnt vmcnt(0)" ::: "memory")
__device__ __forceinline__ unsigned f2bf(float f) { unsigned u = __builtin_bit_cast(unsigned, f); return (u + 0x7fffu + ((u >> 16) & 1u)) >> 16; }
__device__ __forceinline__ unsigned pk2(float lo, float hi) { return f2bf(lo) | (f2bf(hi) << 16); }
__device__ __forceinline__ float bflo(unsigned w) { return __builtin_bit_cast(float, w << 16); }
__device__ __forceinline__ float bfhi(unsigned w) { return __builtin_bit_cast(float, w & 0xffff0000u); }

#define XB_TMO      128
#define XB_XCNT(j)  (256  + 64 * (j))
#define XB_XSUB(j)  (1280 + 64 * (j))
#define XB_XGEN(j)  (2304 + 64 * (j))
#define XB_TOP      3328
#define XB_TOPGEN   3392
#define XCD_BAR_WORDS 3456
#define XB_SPIN_CAP (1u << 18)

__device__ __forceinline__ unsigned xb_ld(unsigned* p)              { return __hip_atomic_load(p, __ATOMIC_RELAXED, __HIP_MEMORY_SCOPE_AGENT); }
__device__ __forceinline__ unsigned xb_add(unsigned* p, unsigned v) { return __hip_atomic_fetch_add(p, v, __ATOMIC_RELAXED, __HIP_MEMORY_SCOPE_AGENT); }
__device__ __forceinline__ unsigned xb_xcc_id() { return (unsigned)__builtin_amdgcn_s_getreg((3 << 11) | 20) & 0xFu; }
#define XB_SPIN(cond, bar) do { unsigned _sp = 0; while (cond) { __builtin_amdgcn_s_sleep(1); \
    if ((++_sp & 255u) == 0u) { if (xb_ld(&(bar)[XB_TMO])) break; if (_sp > XB_SPIN_CAP) { atomicAdd(&(bar)[XB_TMO], 1u); break; } } } } while (0)

struct XcdBarrier {
    unsigned* bar; unsigned x;
    volatile LAS unsigned* st;
};

__device__ __forceinline__ XcdBarrier xcd_barrier_post(unsigned* bar, volatile LAS unsigned* st) {
    XcdBarrier b; b.bar = bar; b.x = xb_xcc_id(); b.st = st;
    if (threadIdx.x == 0) (void)xb_add(&bar[XB_XCNT(b.x)], 1u);
    return b;
}
__device__ __forceinline__ void xcd_barrier_complete(unsigned* bar, unsigned x, unsigned& nloc, unsigned& nx) {
    const unsigned G = gridDim.x * gridDim.y * gridDim.z;
    unsigned sum, cnt, mine, sp = 0u;
    for (;;) {
        sum = 0u; cnt = 0u; mine = 0u;
#pragma unroll
        for (unsigned j = 0; j < 16; ++j) { const unsigned c = xb_ld(&bar[XB_XCNT(j)]); sum += c; cnt += (c > 0u) ? 1u : 0u; mine = (j == x) ? c : mine; }
        if (sum == G) break;
        __builtin_amdgcn_s_sleep(1);
        if ((++sp & 255u) == 0u) { if (xb_ld(&bar[XB_TMO])) break; if (sp > XB_SPIN_CAP) { atomicAdd(&bar[XB_TMO], 1u); break; } }
    }
    nloc = mine > 0u ? mine : 1u; nx = cnt > 0u ? cnt : 1u;
}

__device__ __forceinline__ void xcd_barrier(const XcdBarrier& b) {
    asm volatile("s_waitcnt vmcnt(0)" ::: "memory");
    __syncthreads();
    if (threadIdx.x == 0) {
        unsigned* bar = b.bar;
        __builtin_amdgcn_s_waitcnt(0);
        unsigned nloc = b.st[0], nx = b.st[1];
        if (nloc == 0u) { xcd_barrier_complete(bar, b.x, nloc, nx); b.st[0] = nloc; b.st[1] = nx; }
        const unsigned old = xb_add(&bar[XB_XSUB(b.x)], 1u);
        const unsigned gen = old / nloc;
        if (old + 1u == (gen + 1u) * nloc) {
            __builtin_amdgcn_fence(__ATOMIC_RELEASE, "agent");
            asm volatile("s_waitcnt vmcnt(0)" ::: "memory");
            const unsigned og = xb_add(&bar[XB_TOP], 1u);
            const unsigned tg = og / nx;
            if (og + 1u == (tg + 1u) * nx) xb_add(&bar[XB_TOPGEN], 1u);
            else XB_SPIN(xb_ld(&bar[XB_TOPGEN]) == tg, bar);
            __builtin_amdgcn_fence(__ATOMIC_ACQUIRE, "agent");
            xb_add(&bar[XB_XGEN(b.x)], 1u);
            asm volatile("s_waitcnt vmcnt(0)" ::: "memory");
        } else {
            XB_SPIN(xb_ld(&bar[XB_XGEN(b.x)]) == gen, bar);
            __builtin_amdgcn_fence(__ATOMIC_ACQUIRE, "agent");
            asm volatile("s_waitcnt vmcnt(0)" ::: "memory");
        }
    }
    __syncthreads();
}

#define WSWZ(v, k) __builtin_bit_cast(float, __builtin_amdgcn_ds_swizzle(__builtin_bit_cast(int, v), 0x1F | ((k) << 10)))
__device__ __forceinline__ float wave_sum(float v) {
    v += WSWZ(v, 1); v += WSWZ(v, 2); v += WSWZ(v, 4); v += WSWZ(v, 8); v += WSWZ(v, 16);
    auto rr = __builtin_amdgcn_permlane32_swap(__float_as_uint(v), __float_as_uint(v), false, false); return __uint_as_float(rr[0]) + __uint_as_float(rr[1]);
}
__device__ __forceinline__ float wave_max(float v) {
    v = fmaxf(v, WSWZ(v, 1)); v = fmaxf(v, WSWZ(v, 2)); v = fmaxf(v, WSWZ(v, 4)); v = fmaxf(v, WSWZ(v, 8)); v = fmaxf(v, WSWZ(v, 16));
    auto rr = __builtin_amdgcn_permlane32_swap(__float_as_uint(v), __float_as_uint(v), false, false); return fmaxf(__uint_as_float(rr[0]), __uint_as_float(rr[1]));
}
__device__ __forceinline__ unsigned q8(float v, float inv) { return (unsigned)(int)__builtin_rintf(v * inv) & 0xffu; }
__device__ __forceinline__ void p0_transpose_item(const float* W, int K, int N, int ncols, bf16* WT, int blk, int stride, int off, LAS float* scr, int item, int lane, unsigned* cmax = nullptr) {
    const int nblk = ncols / 32, kb = item / nblk, nb = item % nblk, k0 = 64 * kb, n0 = 32 * nb;
    const int r0 = (n0 / blk) * stride + off + n0 % blk;
#pragma unroll 8
    for (int i = 0; i < 32; ++i) { const int kk = 2 * i + (lane >> 5); scr[kk * 33 + (lane & 31)] = W[(size_t)(k0 + kk) * N + n0 + (lane & 31)]; }
    LDS_WAIT(); asm volatile("" ::: "memory");
    const int c = lane & 7;
#pragma unroll
    for (int j = 0; j < 4; ++j) { const int n = (lane >> 3) + 8 * j; const LAS float* s = scr + (8 * c) * 33 + n;
        const float e0 = s[0 * 33], e1 = s[1 * 33], e2 = s[2 * 33], e3 = s[3 * 33], e4 = s[4 * 33], e5 = s[5 * 33], e6 = s[6 * 33], e7 = s[7 * 33];
        v4u o; o.x = pk2(e0, e1); o.y = pk2(e2, e3); o.z = pk2(e4, e5); o.w = pk2(e6, e7);
        *(GAS v4u*)(WT + (size_t)(r0 + n) * K + k0 + 8 * c) = o;
        if (cmax) {
            float mx = fmaxf(fmaxf(fmaxf(fabsf(e0), fabsf(e1)), fmaxf(fabsf(e2), fabsf(e3))), fmaxf(fmaxf(fabsf(e4), fabsf(e5)), fmaxf(fabsf(e6), fabsf(e7))));
            mx = fmaxf(mx, __shfl_xor(mx, 1)); mx = fmaxf(mx, __shfl_xor(mx, 2)); mx = fmaxf(mx, __shfl_xor(mx, 4));
            if (c == 0) (void)__hip_atomic_fetch_max(cmax + r0 + n, __builtin_bit_cast(unsigned, mx), __ATOMIC_RELAXED, __HIP_MEMORY_SCOPE_AGENT); } }
    LDS_WAIT(); asm volatile("" ::: "memory");
}

struct TDesc { const float* src; unsigned char* dst; const unsigned* cm; int N, pitch, mode; };
typedef float f32x2_t __attribute__((ext_vector_type(2)));
__device__ __forceinline__ void p0_tile_load(const TDesc& t, f32x2_t (&v)[32], int lane) {
    const GAS f32x2_t* p = (const GAS f32x2_t*)(t.src + (size_t)(lane >> 5) * t.N + 2 * (lane & 31)); const size_t st = (size_t)t.N;
#pragma unroll
    for (int i = 0; i < 32; ++i) v[i] = __builtin_nontemporal_load(p + (size_t)i * st);
}
__device__ __forceinline__ void p0_scale_load(const TDesc& t, float (&inv)[8], int lane) {
    if (t.mode != 0) { const float qm = t.mode == 1 ? 127.0f : 448.0f;
#pragma unroll
        for (int j = 0; j < 4; ++j) { const v2u c2 = *(const GAS v2u*)(t.cm + 2 * ((lane >> 3) + 8 * j)); const unsigned u0 = c2.x, u1 = c2.y; const float c0 = __builtin_bit_cast(float, u0), c1 = __builtin_bit_cast(float, u1);
            inv[j] = c0 > 0.f ? qm / c0 : 0.f; inv[4 + j] = c1 > 0.f ? qm / c1 : 0.f; } }
}
__device__ __forceinline__ unsigned q8s(float v, float inv) { return (unsigned)(int)__builtin_rintf(__builtin_amdgcn_fmed3f(v * inv, -127.0f, 127.0f)) & 0xffu; }
__device__ __forceinline__ float f8s(float v, float inv) { return __builtin_amdgcn_fmed3f(v * inv, -448.0f, 448.0f); }
__device__ __forceinline__ void p0_tile_store(const TDesc& t, const f32x2_t (&v)[32], LAS float* scr, int lane, const float (&inv)[8]) {
#pragma unroll
    for (int par = 0; par < 2; ++par) {
#pragma unroll
        for (int i = 0; i < 32; ++i) scr[(2 * i + (lane >> 5)) * 33 + (lane & 31)] = par == 0 ? v[i].x : v[i].y;
        LDS_WAIT(); asm volatile("" ::: "memory");
        const int c = lane & 7;
#pragma unroll
        for (int j = 0; j < 4; ++j) { const int n = (lane >> 3) + 8 * j; const LAS float* s = scr + (8 * c) * 33 + n; unsigned char* drow = t.dst + (size_t)(2 * n + par) * t.pitch;
            const float e0 = s[0 * 33], e1 = s[1 * 33], e2 = s[2 * 33], e3 = s[3 * 33], e4 = s[4 * 33], e5 = s[5 * 33], e6 = s[6 * 33], e7 = s[7 * 33];
            if (t.mode == 0) { v4u o; o.x = pk2(e0, e1); o.y = pk2(e2, e3); o.z = pk2(e4, e5); o.w = pk2(e6, e7);
                *(GAS v4u*)(drow + 16 * c) = o; }
            else if (t.mode == 1) { const float iv = inv[par * 4 + j]; v2u o;
                o.x = q8s(e0, iv) | (q8s(e1, iv) << 8) | (q8s(e2, iv) << 16) | (q8s(e3, iv) << 24); o.y = q8s(e4, iv) | (q8s(e5, iv) << 8) | (q8s(e6, iv) << 16) | (q8s(e7, iv) << 24);
                *(GAS v2u*)(drow + 8 * c) = o; }
            else { const float iv = inv[par * 4 + j]; int w0 = 0, w1 = 0;
                w0 = __builtin_amdgcn_cvt_pk_fp8_f32(f8s(e0, iv), f8s(e1, iv), w0, false); w0 = __builtin_amdgcn_cvt_pk_fp8_f32(f8s(e2, iv), f8s(e3, iv), w0, true);
                w1 = __builtin_amdgcn_cvt_pk_fp8_f32(f8s(e4, iv), f8s(e5, iv), w1, false); w1 = __builtin_amdgcn_cvt_pk_fp8_f32(f8s(e6, iv), f8s(e7, iv), w1, true);
                v2u o; o.x = (unsigned)w0; o.y = (unsigned)w1; *(GAS v2u*)(drow + 8 * c) = o; } }
        LDS_WAIT(); asm volatile("" ::: "memory"); }
}
__device__ __forceinline__ TDesc p0_tile_desc(const float* W, int K, int N, int ncols, unsigned char* WT, int mode, int blk, int stride, int off, int item, int KC, int kt, const unsigned* cmax) {
    const int nblk = ncols / 64, kc = item / nblk, nb = item - kc * nblk, k0 = 64 * (kc * KC + kt), n0 = 64 * nb, r0 = (n0 / blk) * stride + off + n0 % blk;
    const int es = mode == 0 ? 2 : 1;
    TDesc t; t.src = W + (size_t)k0 * N + n0; t.dst = WT + ((size_t)r0 * K + k0) * es; t.cm = cmax ? cmax + r0 : nullptr; t.N = N; t.pitch = K * es; t.mode = mode; return t;
}
constexpr float SAMPLE_MARGIN = 1.4f;
__device__ __forceinline__ void p0_sample_item(const float* W, int K, int N, int n, int q, unsigned* cm, int blk, int stride, int off) {
    const int rs = K / 256;
    const GAS f32x4* p = (const GAS f32x4*)(W + (size_t)(q * 64 * rs + rs / 2) * N + n); const size_t st = (size_t)rs * N / 4;
    f32x4 m = {0.f, 0.f, 0.f, 0.f};
#pragma unroll 1
    for (int s0 = 0; s0 < 64; s0 += 16) { f32x4 v[16];
#pragma unroll
        for (int s = 0; s < 16; ++s) v[s] = p[(size_t)(s0 + s) * st];
#pragma unroll
        for (int s = 0; s < 16; ++s) { m.x = fmaxf(m.x, fabsf(v[s].x)); m.y = fmaxf(m.y, fabsf(v[s].y)); m.z = fmaxf(m.z, fabsf(v[s].z)); m.w = fmaxf(m.w, fabsf(v[s].w)); } }
    unsigned* c = cm + (n / blk) * stride + off + n % blk;
    (void)__hip_atomic_fetch_max(c + 0, __builtin_bit_cast(unsigned, m.x * SAMPLE_MARGIN), __ATOMIC_RELAXED, __HIP_MEMORY_SCOPE_AGENT);
    (void)__hip_atomic_fetch_max(c + 1, __builtin_bit_cast(unsigned, m.y * SAMPLE_MARGIN), __ATOMIC_RELAXED, __HIP_MEMORY_SCOPE_AGENT);
    (void)__hip_atomic_fetch_max(c + 2, __builtin_bit_cast(unsigned, m.z * SAMPLE_MARGIN), __ATOMIC_RELAXED, __HIP_MEMORY_SCOPE_AGENT);
    (void)__hip_atomic_fetch_max(c + 3, __builtin_bit_cast(unsigned, m.w * SAMPLE_MARGIN), __ATOMIC_RELAXED, __HIP_MEMORY_SCOPE_AGENT);
}
__device__ __forceinline__ void p0_requant_load(const bf16* src, v4u (&v)[8], int lane) {
    const GAS v4u* sr = (const GAS v4u*)src + lane;
#pragma unroll
    for (int j = 0; j < 8; ++j) v[j] = __builtin_nontemporal_load(sr + 64 * j);
}
__device__ __forceinline__ void p0_requant_store(const v4u (&v)[8], unsigned cmbits, unsigned char* dst, int lane) {
    GAS v2u* dr = (GAS v2u*)dst + lane;
    const float cm = __builtin_bit_cast(float, cmbits); const float inv = cm > 0.f ? 127.0f / cm : 0.f;
#pragma unroll
    for (int j = 0; j < 8; ++j) { const v4u w = v[j]; v2u o;
        o.x = q8(bflo(w.x), inv) | (q8(bfhi(w.x), inv) << 8) | (q8(bflo(w.y), inv) << 16) | (q8(bfhi(w.y), inv) << 24);
        o.y = q8(bflo(w.z), inv) | (q8(bfhi(w.z), inv) << 8) | (q8(bflo(w.w), inv) << 16) | (q8(bfhi(w.w), inv) << 24);
        dr[64 * j] = o; }
}
__device__ __forceinline__ void p0_requant_row_f8(const bf16* src, unsigned cmbits, unsigned char* dst, int K, int lane) {
    const GAS v4u* sr = (const GAS v4u*)src; GAS v2u* dr = (GAS v2u*)dst;
    const float cm = __builtin_bit_cast(float, cmbits); const float inv = cm > 0.f ? 448.0f / cm : 0.f;
    for (int i = lane; i < K / 8; i += 64) { const v4u w = __builtin_nontemporal_load(sr + i); int w0 = 0, w1 = 0;
        w0 = __builtin_amdgcn_cvt_pk_fp8_f32(bflo(w.x) * inv, bfhi(w.x) * inv, w0, false); w0 = __builtin_amdgcn_cvt_pk_fp8_f32(bflo(w.y) * inv, bfhi(w.y) * inv, w0, true);
        w1 = __builtin_amdgcn_cvt_pk_fp8_f32(bflo(w.z) * inv, bfhi(w.z) * inv, w1, false); w1 = __builtin_amdgcn_cvt_pk_fp8_f32(bflo(w.w) * inv, bfhi(w.w) * inv, w1, true);
        v2u o; o.x = (unsigned)w0; o.y = (unsigned)w1; dr[i] = o; }
}
__device__ __forceinline__ const void* uni_ptr(const void* p) { const unsigned long long u = (unsigned long long)p; const unsigned lo = __builtin_amdgcn_readfirstlane((unsigned)u), hi = __builtin_amdgcn_readfirstlane((unsigned)(u >> 32)); return (const void*)(((unsigned long long)hi << 32) | lo); }
__device__ __forceinline__ void st16_wt(const void* ubase, unsigned voff, v4u w) { asm volatile("global_store_dwordx4 %0, %1, %2 sc1\n\ts_nop 1" :: "v"(voff), "v"(w), "s"(ubase) : "memory"); }
#define ST_BF16_PIECE(ubase, lane16, j, w) st16_wt(ubase, (lane16) + 1024u * (unsigned)(j), w)
__device__ __forceinline__ unsigned dpp_swap1(unsigned x) { return (unsigned)__builtin_amdgcn_update_dpp(0, (int)x, 0xB1, 0xf, 0xf, true); }
__device__ __forceinline__ v4u pack8_bf16(const float (&f)[8]) { v4u w; w.x = pk2(f[0], f[1]); w.y = pk2(f[2], f[3]); w.z = pk2(f[4], f[5]); w.w = pk2(f[6], f[7]); return w; }
__device__ __forceinline__ void store_row_i8(const float (&f)[8][8], float inv, const void* urow, int lane) {
    const bool odd = (lane & 1) != 0; const unsigned voff = 8u * (unsigned)(lane & ~1) + (odd ? 512u : 0u);
#pragma unroll
    for (int p = 0; p < 4; ++p) { unsigned a0, a1, b0, b1;
        a0 = q8(f[2 * p][0], inv) | (q8(f[2 * p][1], inv) << 8) | (q8(f[2 * p][2], inv) << 16) | (q8(f[2 * p][3], inv) << 24); a1 = q8(f[2 * p][4], inv) | (q8(f[2 * p][5], inv) << 8) | (q8(f[2 * p][6], inv) << 16) | (q8(f[2 * p][7], inv) << 24);
        b0 = q8(f[2 * p + 1][0], inv) | (q8(f[2 * p + 1][1], inv) << 8) | (q8(f[2 * p + 1][2], inv) << 16) | (q8(f[2 * p + 1][3], inv) << 24); b1 = q8(f[2 * p + 1][4], inv) | (q8(f[2 * p + 1][5], inv) << 8) | (q8(f[2 * p + 1][6], inv) << 16) | (q8(f[2 * p + 1][7], inv) << 24);
        const unsigned r0 = dpp_swap1(odd ? a0 : b0), r1 = dpp_swap1(odd ? a1 : b1);
        v4u w; w.x = odd ? r0 : a0; w.y = odd ? r1 : a1; w.z = odd ? b0 : r0; w.w = odd ? b1 : r1;
        st16_wt(urow, voff + 1024u * (unsigned)p, w); }
}
__device__ __forceinline__ void rms_row_to_bf16(const float* xrow, const LAS float* gain, bf16* hrow, unsigned char* h8row, float* hs, int lane) {
    const GAS f32x4* xr = (const GAS f32x4*)xrow + 2 * lane; const LAS f32x4* gr = (const LAS f32x4*)gain + lane;
    const void* uh = uni_ptr(hrow); const unsigned l16 = 16u * (unsigned)lane;
    float v[8][8]; float s = 0.f;
#pragma unroll
    for (int j = 0; j < 8; ++j) { const f32x4 a = xr[128 * j], b = xr[128 * j + 1];
#pragma unroll
        for (int e = 0; e < 4; ++e) { v[j][e] = a[e]; v[j][4 + e] = b[e]; s += a[e] * a[e] + b[e] * b[e]; } }
    const float rstd = 1.0f / sqrtf(wave_sum(s) * (1.f / DM) + RMS_EPS);
    float am = 0.f;
#pragma unroll
    for (int j = 0; j < 8; ++j) { const f32x4 ga = gr[(2 * j) * 64], gb = gr[(2 * j + 1) * 64];
#pragma unroll
        for (int e = 0; e < 4; ++e) { v[j][e] *= rstd * ga[e]; v[j][4 + e] *= rstd * gb[e]; am = fmaxf(am, fmaxf(fabsf(v[j][e]), fabsf(v[j][4 + e]))); }
        ST_BF16_PIECE(uh, l16, j, pack8_bf16(v[j])); }
    am = wave_max(am); const float inv = am > 0.f ? 127.0f / am : 0.f;
    store_row_i8(v, inv, uni_ptr(h8row), lane);
    if (lane == 0) *hs = am * (1.0f / (127.0f * 127.0f));
}
template <bool XI32, bool XO32, bool HN>
__device__ __forceinline__ void resid_row(const bf16* mrow, const void* xin, const LAS float* gl, void* xout, bf16* hrow, unsigned char* h8row, float* hs, int lane) {
    const GAS v4u* mr = (const GAS v4u*)mrow + lane; const LAS f32x4* g1r = (const LAS f32x4*)gl + lane; const LAS f32x4* g2r = (const LAS f32x4*)(gl + DM) + lane;
    const void* uxo = uni_ptr(xout); const void* uhr = uni_ptr(hrow); const unsigned l16 = 16u * (unsigned)lane;
    v4u mraw[8]; v4u xb[XI32 ? 1 : 8];
#pragma unroll
    for (int j = 0; j < 8; ++j) mraw[j] = mr[64 * j];
    if (!XI32) {
#pragma unroll
        for (int j = 0; j < 8; ++j) xb[j] = ((const GAS v4u*)xin + lane)[64 * j]; }
    float v[8][8]; float s = 0.f;
#pragma unroll
    for (int j = 0; j < 8; ++j) {
#pragma unroll
        for (int e = 0; e < 4; ++e) { const unsigned u = mraw[j][e]; const float a = bflo(u), b = bfhi(u); v[j][2 * e] = a; v[j][2 * e + 1] = b; s += a * a + b * b; } }
    const float r1 = 1.0f / sqrtf(wave_sum(s) * (1.f / DM) + RMS_EPS);
    asm volatile("" ::: "memory");
    float s2 = 0.f;
#pragma unroll
    for (int j = 0; j < 8; ++j) { const f32x4 ga = g1r[(2 * j) * 64], gb = g1r[(2 * j + 1) * 64]; float x[8];
        if (XI32) { const f32x4 xa = ((const GAS f32x4*)xin + 2 * lane)[128 * j], xc = ((const GAS f32x4*)xin + 2 * lane)[128 * j + 1];
#pragma unroll
            for (int e = 0; e < 4; ++e) { x[e] = xa[e]; x[4 + e] = xc[e]; } }
        else {
#pragma unroll
            for (int e = 0; e < 4; ++e) { const unsigned u = xb[j][e]; x[2 * e] = bflo(u); x[2 * e + 1] = bfhi(u); } }
#pragma unroll
        for (int e = 0; e < 4; ++e) { v[j][e] = x[e] + v[j][e] * r1 * ga[e]; v[j][4 + e] = x[4 + e] + v[j][4 + e] * r1 * gb[e]; s2 += v[j][e] * v[j][e] + v[j][4 + e] * v[j][4 + e]; }
        if (XO32) { ((GAS f32x4*)xout + 2 * lane)[128 * j] = (f32x4){v[j][0], v[j][1], v[j][2], v[j][3]}; ((GAS f32x4*)xout + 2 * lane)[128 * j + 1] = (f32x4){v[j][4], v[j][5], v[j][6], v[j][7]}; }
        else ST_BF16_PIECE(uxo, l16, j, pack8_bf16(v[j]));
        asm volatile("" ::: "memory"); }
    if (HN) {
        const float r2 = 1.0f / sqrtf(wave_sum(s2) * (1.f / DM) + RMS_EPS);
        asm volatile("" ::: "memory");
        float am = 0.f;
#pragma unroll
        for (int j = 0; j < 8; ++j) { const f32x4 ga = g2r[(2 * j) * 64], gb = g2r[(2 * j + 1) * 64];
#pragma unroll
            for (int e = 0; e < 4; ++e) { v[j][e] *= r2 * ga[e]; v[j][4 + e] *= r2 * gb[e]; am = fmaxf(am, fmaxf(fabsf(v[j][e]), fabsf(v[j][4 + e]))); }
            if (hrow) ST_BF16_PIECE(uhr, l16, j, pack8_bf16(v[j])); }
        am = wave_max(am); const float inv = am > 0.f ? 127.0f / am : 0.f;
        store_row_i8(v, inv, uni_ptr(h8row), lane);
        if (lane == 0) *hs = am * (1.0f / (127.0f * 127.0f));
    }
}
__device__ __forceinline__ void stage_gains(LAS float* gl, const float* g1, const float* g2, int tid) {
    for (int i = tid; i < DM / 4; i += NWAVES * 64) { const int j = i >> 7, l = (i >> 1) & 63, q = i & 1, d = (2 * j + q) * 64 + l;
        ((LAS f32x4*)gl)[d] = ((const GAS f32x4*)g1)[i]; if (g2) ((LAS f32x4*)(gl + DM))[d] = ((const GAS f32x4*)g2)[i]; }
    LDS_WAIT(); __syncthreads();
}
__device__ __forceinline__ void mixnorm_row(const bf16* yrow, const LAS float* gain, unsigned char* yn8row, float* ys, int lane) {
    const GAS v4u* yr = (const GAS v4u*)yrow + lane; const LAS f32x4* gr = (const LAS f32x4*)gain + lane;
    v4u v[8]; float f[8][8]; float am = 0.f;
#pragma unroll
    for (int j = 0; j < 8; ++j) v[j] = yr[64 * j];
#pragma unroll
    for (int g = 0; g < 4; ++g) { float s = 0.f;
#pragma unroll
        for (int jj = 0; jj < 2; ++jj) { const v4u w = v[2 * g + jj];
#pragma unroll
            for (int e = 0; e < 4; ++e) { const unsigned u = w[e]; const float a = bflo(u), b = bfhi(u); f[2 * g + jj][2 * e] = a; f[2 * g + jj][2 * e + 1] = b; s += a * a + b * b; } }
        const float rstd = 1.0f / sqrtf(wave_sum(s) * (1.f / GW) + RMS_EPS);
#pragma unroll
        for (int jj = 0; jj < 2; ++jj) { const int j = 2 * g + jj; const f32x4 ga = gr[(2 * j) * 64], gb = gr[(2 * j + 1) * 64];
#pragma unroll
            for (int e = 0; e < 4; ++e) { f[j][e] *= rstd * ga[e]; f[j][4 + e] *= rstd * gb[e]; am = fmaxf(am, fmaxf(fabsf(f[j][e]), fabsf(f[j][4 + e]))); } }
    }
    am = wave_max(am); const float inv = am > 0.f ? 127.0f / am : 0.f;
    store_row_i8(f, inv, uni_ptr(yn8row), lane);
    if (lane == 0) *ys = am * (1.0f / (127.0f * 127.0f));
}

namespace att {
constexpr int KVBLK = 64, SHM_K = 16384, SHM_V = 16384;
constexpr int OFF_V = 0, OFF_K = 2 * SHM_V, OFF_WS = OFF_K + 2 * SHM_K, OFF_KM = OFF_WS + NWAVES * 64 * 4, OFF_DONE = OFF_KM + 8 * 128 * 4, ATT_LDS = OFF_DONE + 64;
static_assert(ATT_LDS <= RING_BYTES, "attention LDS inside the ring region");
constexpr float C2 = 0.08838834764831845f * 1.4426950408889634f;
constexpr int LDP = INW;
#define KSWZ(row, colB) ((row) * 256 + ((colB) ^ (((row) & 15) << 4)))
#define SBAR() __builtin_amdgcn_sched_barrier(0)
__device__ __forceinline__ int v_st(int k, int c) { const int kk = (k & ~0xC) | ((k & 4) << 1) | ((k & 8) >> 1); return ((kk >> 3) * 4 + (c >> 5)) * 512 + ((kk & 7) * 32 + (c & 31)) * 2; }
__device__ __forceinline__ int v_rd_base(int lane) { return ((lane & 3) << 3) | (((lane >> 2) & 3) << 6) | (((lane >> 4) & 1) << 5) | (((lane >> 5) & 1) << 8); }
constexpr int v_rd_off(int d0, int ks, int half) { return d0 * 512 + ks * 4096 + half * 2048; }
__device__ __forceinline__ int crow(int r, int hi) { return (r & 3) + 8 * (r >> 2) + 4 * hi; }
typedef float f32x2_cv __attribute__((ext_vector_type(2))); typedef __bf16 bf16x2_cv __attribute__((ext_vector_type(2)));
__device__ __forceinline__ unsigned cvtpk(float lo, float hi) { const f32x2_cv v = {lo, hi}; return __builtin_bit_cast(unsigned, __builtin_convertvector(v, bf16x2_cv)); }
__device__ __forceinline__ float swap_max(float v) { auto rr = __builtin_amdgcn_permlane32_swap(__float_as_uint(v), __float_as_uint(v), false, false); return fmaxf(__uint_as_float(rr[0]), __uint_as_float(rr[1])); }
__device__ __forceinline__ float swap_sum(float v) { auto rr = __builtin_amdgcn_permlane32_swap(__float_as_uint(v), __float_as_uint(v), false, false); return __uint_as_float(rr[0]) + __uint_as_float(rr[1]); }

__device__ __forceinline__ void qkt(f32x16& p0, f32x16& p1, const LAS char* Kt, int r32, int hi, const bf16x8* qr) {
    p0 = f32x16{}; p1 = f32x16{};
    int ko[4];
#pragma unroll
    for (int dd = 0; dd < 4; ++dd) ko[dd] = KSWZ(r32, (dd * 16 + hi * 8) * 2);
    bf16x8 fa[8], fb[8];
#pragma unroll
    for (int i = 0; i < 4; ++i) { fa[2 * i] = *(const LAS bf16x8*)(Kt + ko[i]); fa[2 * i + 1] = *(const LAS bf16x8*)(Kt + ko[i] + 32 * 256); }
    asm volatile("" : "+v"(fa[0]), "+v"(fa[1]), "+v"(fa[2]), "+v"(fa[3]), "+v"(fa[4]), "+v"(fa[5]), "+v"(fa[6]), "+v"(fa[7]));
    __builtin_amdgcn_s_setprio(1);
#pragma unroll
    for (int i = 0; i < 4; ++i) { p0 = __builtin_amdgcn_mfma_f32_32x32x16_bf16(fa[2 * i], qr[i], p0, 0, 0, 0); p1 = __builtin_amdgcn_mfma_f32_32x32x16_bf16(fa[2 * i + 1], qr[i], p1, 0, 0, 0); }
    __builtin_amdgcn_s_setprio(0);
#pragma unroll
    for (int i = 0; i < 4; ++i) { fb[2 * i] = *(const LAS bf16x8*)(Kt + (ko[i] ^ 128)); fb[2 * i + 1] = *(const LAS bf16x8*)(Kt + (ko[i] ^ 128) + 32 * 256); }
    asm volatile("" : "+v"(fb[0]), "+v"(fb[1]), "+v"(fb[2]), "+v"(fb[3]), "+v"(fb[4]), "+v"(fb[5]), "+v"(fb[6]), "+v"(fb[7]));
    __builtin_amdgcn_s_setprio(1);
#pragma unroll
    for (int i = 0; i < 4; ++i) { p0 = __builtin_amdgcn_mfma_f32_32x32x16_bf16(fb[2 * i], qr[4 + i], p0, 0, 0, 0); p1 = __builtin_amdgcn_mfma_f32_32x32x16_bf16(fb[2 * i + 1], qr[4 + i], p1, 0, 0, 0); }
    __builtin_amdgcn_s_setprio(0);
}
__device__ __forceinline__ void pv_tile(f32x16* o, unsigned vb, bf16x8 pa0, bf16x8 pa1, bf16x8 pa2, bf16x8 pa3) {
#define TRRD(dst, off) asm volatile("ds_read_b64_tr_b16 %0, %1 offset:%2" : "=&v"(dst) : "v"(vb), "i"(off) : "memory")
#define PV_RD(S, d0) do { constexpr int b_ = v_rd_off(d0, 0, 0); TRRD(S##l0, b_); TRRD(S##h0, b_ + 2048); TRRD(S##l1, b_ + 4096); TRRD(S##h1, b_ + 6144); TRRD(S##l2, b_ + 8192); TRRD(S##h2, b_ + 10240); TRRD(S##l3, b_ + 12288); TRRD(S##h3, b_ + 14336); } while (0)
#define PV_MM(S, d0) do { __builtin_amdgcn_s_setprio(1); \
        o[d0] = __builtin_amdgcn_mfma_f32_32x32x16_bf16(pa0, (bf16x8){S##l0[0], S##l0[1], S##l0[2], S##l0[3], S##h0[0], S##h0[1], S##h0[2], S##h0[3]}, o[d0], 0, 0, 0); \
        o[d0] = __builtin_amdgcn_mfma_f32_32x32x16_bf16(pa1, (bf16x8){S##l1[0], S##l1[1], S##l1[2], S##l1[3], S##h1[0], S##h1[1], S##h1[2], S##h1[3]}, o[d0], 0, 0, 0); \
        o[d0] = __builtin_amdgcn_mfma_f32_32x32x16_bf16(pa2, (bf16x8){S##l2[0], S##l2[1], S##l2[2], S##l2[3], S##h2[0], S##h2[1], S##h2[2], S##h2[3]}, o[d0], 0, 0, 0); \
        o[d0] = __builtin_amdgcn_mfma_f32_32x32x16_bf16(pa3, (bf16x8){S##l3[0], S##l3[1], S##l3[2], S##l3[3], S##h3[0], S##h3[1], S##h3[2], S##h3[3]}, o[d0], 0, 0, 0); __builtin_amdgcn_s_setprio(0); } while (0)
    s16x4 Al0, Al1, Al2, Al3, Ah0, Ah1, Ah2, Ah3, Bl0, Bl1, Bl2, Bl3, Bh0, Bh1, Bh2, Bh3;
    PV_RD(A, 0);
    PV_RD(B, 1); asm volatile("s_waitcnt lgkmcnt(8)" ::: "memory"); SBAR(); PV_MM(A, 0); SBAR();
    PV_RD(A, 2); asm volatile("s_waitcnt lgkmcnt(8)" ::: "memory"); SBAR(); PV_MM(B, 1); SBAR();
    PV_RD(B, 3); asm volatile("s_waitcnt lgkmcnt(8)" ::: "memory"); SBAR(); PV_MM(A, 2); SBAR();
    asm volatile("s_waitcnt lgkmcnt(0)" ::: "memory"); SBAR(); PV_MM(B, 3);
#undef PV_MM
#undef PV_RD
#undef TRRD
}
__device__ __forceinline__ void pack_p(const f32x16& p0, const f32x16& p1, bf16x8& pa0, bf16x8& pa1, bf16x8& pa2, bf16x8& pa3) {
#define PK4(P, B_, OUT) do { unsigned a0 = cvtpk(P[B_+0], P[B_+1]), a1 = cvtpk(P[B_+2], P[B_+3]); \
        unsigned b0 = cvtpk(P[B_+4], P[B_+5]), b1 = cvtpk(P[B_+6], P[B_+7]); \
        auto r0 = __builtin_amdgcn_permlane32_swap(a0, b0, false, false); auto r1 = __builtin_amdgcn_permlane32_swap(a1, b1, false, false); \
        v4u w = {r0[0], r1[0], r0[1], r1[1]}; OUT = __builtin_bit_cast(bf16x8, w); } while (0)
    PK4(p0, 0, pa0); PK4(p0, 8, pa1); PK4(p1, 0, pa2); PK4(p1, 8, pa3);
#undef PK4
}

template <int MODE>
__device__ __forceinline__ void attn_block(const bf16* __restrict__ proj, bf16* __restrict__ y, const float* __restrict__ ksum, int b, int h, int qb, LAS char* lds) {
    int tid = threadIdx.x; asm volatile("" : "+v"(tid));
    const int wid = __builtin_amdgcn_readfirstlane(tid >> 6), lane = tid & 63, r32 = lane & 31, hi = lane >> 5;
    constexpr int QCOL = MODE == 0 ? 0 : (MODE == 1 ? 6144 : 3072), YCOL = MODE == 0 ? 0 : (MODE == 1 ? 3072 : 1024);
    const size_t rowbase = (size_t)b * SEQ; const int q0 = qb * 256;
    const bf16* Kg = proj + rowbase * LDP + QCOL + GW + h * HD; const bf16* Vg = Kg + GW;
    LAS char* V_lds = lds + OFF_V; LAS char* K_lds = lds + OFF_K;
    LAS float* ws = (LAS float*)(lds + OFF_WS) + wid * 64; LAS float* li_l = ws; LAS float* al_l = ws + 32;
    LAS float* km = (LAS float*)(lds + OFF_KM); LAS unsigned* donef = (LAS unsigned*)(lds + OFF_DONE);
    const int sr = tid >> 4, sc = (tid & 15) * 8, vst0 = v_st(sr, sc), vst1 = v_st(32 + sr, sc), kws = KSWZ(sr, sc * 2);
    const unsigned vb0 = (unsigned)(uintptr_t)V_lds + (unsigned)v_rd_base(lane);
    const int qpos = q0 + wid * 32 + r32;
    const int NT = 4 * (qb + 1);
    bf16x8 qr[8];
    { const bf16* Qp = proj + (rowbase + qpos) * LDP + QCOL + h * HD + hi * 8;
#pragma unroll
      for (int d0 = 0; d0 < 8; ++d0) qr[d0] = *(const GAS bf16x8*)(Qp + d0 * 16); }
    bf16x8 st_k0, st_k1, st_v0, st_v1;
#define TILE_OF(it) (MODE == 2 ? (NT - 1 - (it)) : (it))
#define SLOAD(kb) do { const bf16* kp_ = Kg + (size_t)((kb) + sr) * LDP + sc; const bf16* vp_ = Vg + (size_t)((kb) + sr) * LDP + sc; \
        st_k0 = *(const GAS bf16x8*)kp_; st_k1 = *(const GAS bf16x8*)(kp_ + 32 * LDP); st_v0 = *(const GAS bf16x8*)vp_; st_v1 = *(const GAS bf16x8*)(vp_ + 32 * LDP); } while (0)
#define SWRITE(bf) do { *(LAS bf16x8*)(K_lds + (bf) * SHM_K + kws) = st_k0; *(LAS bf16x8*)(K_lds + (bf) * SHM_K + kws + 32 * 256) = st_k1; \
        *(LAS bf16x8*)(V_lds + (bf) * SHM_V + vst0) = st_v0; *(LAS bf16x8*)(V_lds + (bf) * SHM_V + vst1) = st_v1; } while (0)
    SLOAD(TILE_OF(0) * KVBLK);
    unsigned selmask = 0u;
    if (MODE == 0) {
        if (qb > 0) { for (int i = tid; i < qb * 32; i += 512) { const int n = i >> 5, c4 = (i & 31) * 4;
            *(LAS f32x4*)(km + n * 128 + c4) = *(const GAS f32x4*)(ksum + (size_t)(b * 8 + n) * 1024 + h * HD + c4); } }
    }
    SWRITE(0);
    __syncthreads();
    if (MODE == 0 && qb > 0) {
        float g[7];
#pragma unroll
        for (int n = 0; n < 7; ++n) { float a = 0.f;
            if (n < qb) {
#pragma unroll
                for (int d0 = 0; d0 < 8; ++d0) { const f32x4 ka = *(const LAS f32x4*)(km + n * 128 + d0 * 16 + hi * 8), kb2 = *(const LAS f32x4*)(km + n * 128 + d0 * 16 + hi * 8 + 4);
                    const v4u qw = __builtin_bit_cast(v4u, qr[d0]);
                    a += bflo(qw.x) * ka.x + bfhi(qw.x) * ka.y + bflo(qw.y) * ka.z + bfhi(qw.y) * ka.w + bflo(qw.z) * kb2.x + bfhi(qw.z) * kb2.y + bflo(qw.w) * kb2.z + bfhi(qw.w) * kb2.w; }
                a = swap_sum(a); }
            g[n] = a; }
#pragma unroll
        for (int n = 0; n < 7; ++n) { int rank = 0;
#pragma unroll
            for (int m2 = 0; m2 < 7; ++m2) if (m2 != n) rank += (m2 < qb && (g[m2] > g[n] || (g[m2] == g[n] && m2 < n))) ? 1 : 0;
            if (n < qb && rank < 3) selmask |= 1u << n; }
    }
    unsigned m16mask = 0u, m4mask = 0u;
    if (MODE == 1) {
#pragma unroll
        for (int r = 0; r < 16; ++r) { const int c = (r & 3) + 8 * (r >> 2); if (((qpos - 4 * hi - c) & 15) == 0) m16mask |= 1u << r; }
#pragma unroll
        for (int r = 0; r < 4; ++r) if (((qpos - 4 * hi - r) & 3) == 0) m4mask |= 1u << r;
    }
    float m_run = -1e30f, l_run = 0.f, R2 = 0.f; f32x16 o[4] = {};
    const int qhi = q0 + wid * 32 + 31;
    bool wdone = false;
    for (int it = 0; it < NT; ++it) {
        const int j = TILE_OF(it), kbase = j * KVBLK, buf = it & 1;
        const bool more = it + 1 < NT;
        if (more) SLOAD(TILE_OF(it + 1) * KVBLK);
        bool act;
        if (MODE == 0) act = (j >> 2) == qb ? (kbase <= qhi) : (__any((selmask >> (j >> 2)) & 1u) != 0);
        else if (MODE == 1) act = kbase <= qhi;
        else act = (kbase < qhi) && !wdone;
        if (act) {
            f32x16 p0, p1;
            qkt(p0, p1, K_lds + buf * SHM_K, r32, hi, qr); SBAR();
            const int dq = qpos - kbase - 4 * hi;
            bf16x8 pa0, pa1, pa2, pa3;
            if (MODE == 2) {
                f32x16 z0, z1;
#pragma unroll
                for (int r = 0; r < 16; ++r) { z0[r] = p0[r] * C2; z1[r] = p1[r] * C2; }
#pragma unroll
                for (int r = 0; r < 16; ++r) { const int c = (r & 3) + 8 * (r >> 2);
                    const float t0 = __builtin_amdgcn_exp2f(-fabsf(z0[r])), t1 = __builtin_amdgcn_exp2f(-fabsf(z1[r]));
                    const float s0 = fmaxf(z0[r], 0.f) + __builtin_amdgcn_logf(1.0f + t0), s1 = fmaxf(z1[r], 0.f) + __builtin_amdgcn_logf(1.0f + t1);
                    p0[r] = (dq - c >= 1) ? -s0 : 0.f; p1[r] = (dq - c - 32 >= 1) ? -s1 : 0.f; }
                float G[8], T[8];
#pragma unroll
                for (int k = 0; k < 8; ++k) { G[k] = k < 4 ? (p0[4 * k] + p0[4 * k + 1]) + (p0[4 * k + 2] + p0[4 * k + 3]) : (p1[4 * k - 16] + p1[4 * k - 15]) + (p1[4 * k - 14] + p1[4 * k - 13]);
                    T[k] = swap_sum(G[k]); }
                float st = 0.f;
#pragma unroll
                for (int k = 7; k >= 0; --k) { const float eg = R2 + st + (hi == 0 ? T[k] - G[k] : 0.f);
                    st += T[k];
                    if (k < 4) { const float l3 = p0[4 * k + 3], l2 = p0[4 * k + 2], l1 = p0[4 * k + 1], l0 = p0[4 * k];
                        const float e3 = eg, e2 = eg + l3, e1 = e2 + l2, e0 = e1 + l1;
                        p0[4 * k + 3] = z0[4 * k + 3] + l3 + e3; p0[4 * k + 2] = z0[4 * k + 2] + l2 + e2; p0[4 * k + 1] = z0[4 * k + 1] + l1 + e1; p0[4 * k] = z0[4 * k] + l0 + e0; }
                    else { const int q4 = 4 * k - 16; const float l3 = p1[q4 + 3], l2 = p1[q4 + 2], l1 = p1[q4 + 1], l0 = p1[q4];
                        const float e3 = eg, e2 = eg + l3, e1 = e2 + l2, e0 = e1 + l1;
                        p1[q4 + 3] = z1[q4 + 3] + l3 + e3; p1[q4 + 2] = z1[q4 + 2] + l2 + e2; p1[q4 + 1] = z1[q4 + 1] + l1 + e1; p1[q4] = z1[q4] + l0 + e0; } }
                R2 += st;
#pragma unroll
                for (int r = 0; r < 16; ++r) { const int c = (r & 3) + 8 * (r >> 2);
                    p0[r] = (dq - c >= 1) ? __builtin_amdgcn_exp2f(p0[r]) : 0.f; p1[r] = (dq - c - 32 >= 1) ? __builtin_amdgcn_exp2f(p1[r]) : 0.f; }
                SBAR(); pack_p(p0, p1, pa0, pa1, pa2, pa3); SBAR();
                pv_tile(o, vb0 + buf * SHM_V, pa0, pa1, pa2, pa3);
                wdone = __all(R2 < -150.f) != 0;
            } else {
                const float NEG = -__builtin_inff();
                constexpr float THR2 = 11.5f;
                float nb;
                float pmax;
                if (MODE == 0) {
                    const bool own = (j >> 2) == qb;
                    if (own) {
#pragma unroll
                        for (int r = 0; r < 16; ++r) { const int c = (r & 3) + 8 * (r >> 2); p0[r] = (dq - c >= 0) ? p0[r] : NEG; p1[r] = (dq - c - 32 >= 0) ? p1[r] : NEG; } }
                    pmax = p0[0];
#pragma unroll
                    for (int r = 1; r < 16; ++r) pmax = fmaxf(pmax, p0[r]);
#pragma unroll
                    for (int r = 0; r < 16; ++r) pmax = fmaxf(pmax, p1[r]);
                    const bool sel = own || (((selmask >> (j >> 2)) & 1u) != 0u);
                    pmax = swap_max(sel ? pmax * C2 : NEG);
                    float mn = m_run, alpha = 1.0f;
                    if (!__all(pmax - m_run <= THR2)) { mn = fmaxf(m_run, pmax); alpha = __builtin_amdgcn_exp2f(m_run - mn); m_run = mn;
                        if (hi == 0) al_l[r32] = alpha; LDS_WAIT();
#pragma unroll
                        for (int r = 0; r < 16; ++r) { const float a = al_l[crow(r, hi)];
#pragma unroll
                            for (int d_ = 0; d_ < 4; ++d_) o[d_][r] *= a; }
                        LDS_WAIT(); }
                    nb = sel ? -mn : NEG; float ps = 0.f;
#pragma unroll
                    for (int r = 0; r < 16; ++r) { p0[r] = __builtin_amdgcn_exp2f(fmaf(p0[r], C2, nb)); p1[r] = __builtin_amdgcn_exp2f(fmaf(p1[r], C2, nb)); ps += p0[r] + p1[r]; }
                    ps = swap_sum(ps);
                    l_run = l_run * alpha + ps;
                } else {
                    const int qlo = qhi - 31;
                    unsigned m16_l = m16mask, m4_l = m4mask; asm volatile("" : "+v"(m16_l), "+v"(m4_l));
                    if (kbase + 63 < qlo - 512) {
#pragma unroll
                        for (int r = 0; r < 16; ++r) { const float bf_ = ((m16_l >> r) & 1u) ? 0.0f : NEG; p0[r] = fmaf(p0[r], C2, bf_); p1[r] = fmaf(p1[r], C2, bf_); }
                    } else if (kbase + 63 < qlo - 128 && kbase >= qhi - 512) {
#pragma unroll
                        for (int r = 0; r < 16; ++r) { const float bm_ = ((m4_l >> (r & 3)) & 1u) ? (((m16_l >> r) & 1u) ? 1.0f : 0.0f) : NEG; p0[r] = fmaf(p0[r], C2, bm_); p1[r] = fmaf(p1[r], C2, bm_); }
                    } else {
#pragma unroll
                        for (int r = 0; r < 16; ++r) { const int c = (r & 3) + 8 * (r >> 2); const int m4_ = (int)((m4_l >> (r & 3)) & 1u), m16_ = (int)((m16_l >> r) & 1u);
                            const int d0_ = dq - c, d1_ = d0_ - 32;
                            const int c0_ = ((unsigned)d0_ <= 128u ? 1 : 0) + (((unsigned)d0_ <= 512u ? 1 : 0) & m4_) + ((d0_ >= 0 ? 1 : 0) & m16_);
                            const int c1_ = ((unsigned)d1_ <= 128u ? 1 : 0) + (((unsigned)d1_ <= 512u ? 1 : 0) & m4_) + ((d1_ >= 0 ? 1 : 0) & m16_);
                            const float l0_ = c0_ == 0 ? NEG : (c0_ == 3 ? 1.5849625007211562f : (float)(c0_ - 1)), l1_ = c1_ == 0 ? NEG : (c1_ == 3 ? 1.5849625007211562f : (float)(c1_ - 1));
                            p0[r] = fmaf(p0[r], C2, l0_); p1[r] = fmaf(p1[r], C2, l1_); }
                    }
                    pmax = p0[0];
#pragma unroll
                    for (int r = 1; r < 16; ++r) pmax = fmaxf(pmax, p0[r]);
#pragma unroll
                    for (int r = 0; r < 16; ++r) pmax = fmaxf(pmax, p1[r]);
                    pmax = swap_max(pmax);
                    float mn = m_run, alpha = 1.0f;
                    if (!__all(pmax - m_run <= THR2)) { mn = fmaxf(m_run, pmax); alpha = __builtin_amdgcn_exp2f(m_run - mn); m_run = mn;
                        if (hi == 0) al_l[r32] = alpha; LDS_WAIT();
#pragma unroll
                        for (int r = 0; r < 16; ++r) { const float a = al_l[crow(r, hi)];
#pragma unroll
                            for (int d_ = 0; d_ < 4; ++d_) o[d_][r] *= a; }
                        LDS_WAIT(); }
                    float ps = 0.f;
#pragma unroll
                    for (int r = 0; r < 16; ++r) { p0[r] = __builtin_amdgcn_exp2f(p0[r] - mn); p1[r] = __builtin_amdgcn_exp2f(p1[r] - mn); ps += p0[r] + p1[r]; }
                    ps = swap_sum(ps);
                    l_run = l_run * alpha + ps;
                }
                SBAR(); pack_p(p0, p1, pa0, pa1, pa2, pa3); SBAR();
                pv_tile(o, vb0 + buf * SHM_V, pa0, pa1, pa2, pa3);
            }
        }
        if (more) SWRITE(buf ^ 1);
        if (MODE == 2) { if (lane == 0) donef[(it & 1) * 8 + wid] = wdone ? 1u : 0u; }
        __syncthreads();
        if (MODE == 2) { unsigned alld = 1u;
#pragma unroll
            for (int w8 = 0; w8 < 8; ++w8) alld &= donef[(it & 1) * 8 + w8];
            if (alld) break; }
    }
    if (MODE != 2) { if (hi == 0) li_l[r32] = l_run; LDS_WAIT(); }
    int tz = tid; asm volatile("" : "+v"(tz));
    const int er32 = tz & 31, ehi = (tz >> 5) & 1;
    bf16* Ow = y + (rowbase + q0 + wid * 32 + 4 * ehi) * DM + YCOL + h * HD + er32;
#pragma unroll
    for (int r = 0; r < 16; ++r) { const int orow = (r & 3) + 8 * (r >> 2); const float rl = MODE != 2 ? __builtin_amdgcn_rcpf(li_l[orow + 4 * ehi]) : 1.0f;
#pragma unroll
        for (int d0 = 0; d0 < 4; ++d0) { const float v = o[d0][r] * rl; const float vn = __shfl_xor(v, 1);
            if ((er32 & 1) == 0) *(GAS unsigned*)(Ow + (size_t)orow * DM + d0 * 32) = cvtpk(v, vn); } }
    LDS_WAIT();
    __syncthreads();
#undef TILE_OF
#undef SLOAD
#undef SWRITE
}

typedef float f32x4_t __attribute__((ext_vector_type(4)));
constexpr int POOL_PITCH = 528, POOL_ROWS = 128 + 15;
static_assert(POOL_ROWS * POOL_PITCH <= RING_BYTES, "pool tile inside the ring region");
template <int W>
__device__ __forceinline__ void pool_item_w(const bf16* __restrict__ proj, const bf16* __restrict__ wpt, const float* __restrict__ pscale, bf16* __restrict__ y, int g, int tt, LAS char* lds) {
    int tid = threadIdx.x; asm volatile("" : "+v"(tid));
    const int wid = __builtin_amdgcn_readfirstlane(tid >> 6), lane = tid & 63, c16 = lane & 15, kq = lane >> 4;
    const int t0 = tt * 128, s0 = t0 & (SEQ - 1);
    { const bf16* ug = proj + (size_t)(t0 - 15) * LDP + 9 * GW + g * 256;
#pragma unroll
      for (int j = 0; j < 9; ++j) { const int i = tid + 512 * j; if (i < POOL_ROWS * 32) { const int rr = i >> 5, ch = i & 31;
          v4u v = (v4u){0u, 0u, 0u, 0u}; if (s0 - 15 + rr >= 0) v = *(const GAS v4u*)(ug + (size_t)rr * LDP + ch * 8);
          *(LAS v4u*)(lds + rr * POOL_PITCH + ch * 16) = v; } } }
    __syncthreads();
    const int tl = wid * 16 + c16, t = t0 + tl, s = s0 + tl;
    const int cnt = (s + 1 < W) ? s + 1 : W; const float inv = 1.0f / (float)cnt;
    const LAS char* ul = lds + (15 + tl) * POOL_PITCH + kq * 16;
    const bf16* wb = wpt + (size_t)(g * 256 + c16) * 256 + kq * 8;
    f32x4_t acc[16];
#pragma unroll
    for (int db = 0; db < 16; ++db) acc[db] = (f32x4_t){0.f, 0.f, 0.f, 0.f};
#pragma unroll 1
    for (int ks = 0; ks < 8; ++ks) {
        bf16x8 afr[16];
#pragma unroll
        for (int db = 0; db < 16; ++db) afr[db] = *(const GAS bf16x8*)(wb + (size_t)db * 16 * 256 + ks * 32);
        float sm[8] = {0.f, 0.f, 0.f, 0.f, 0.f, 0.f, 0.f, 0.f}; float u0[8];
#pragma unroll
        for (int jj = 0; jj < W; ++jj) { const v4u q = *(const LAS v4u*)(ul - jj * POOL_PITCH + ks * 64);
            const float e[8] = {bflo(q.x), bfhi(q.x), bflo(q.y), bfhi(q.y), bflo(q.z), bfhi(q.z), bflo(q.w), bfhi(q.w)};
#pragma unroll
            for (int i = 0; i < 8; ++i) { sm[i] += e[i]; if (jj == 0) u0[i] = e[i]; } }
        v4u bw; bw.x = cvtpk(sm[0] * inv - u0[0], sm[1] * inv - u0[1]); bw.y = cvtpk(sm[2] * inv - u0[2], sm[3] * inv - u0[3]);
        bw.z = cvtpk(sm[4] * inv - u0[4], sm[5] * inv - u0[5]); bw.w = cvtpk(sm[6] * inv - u0[6], sm[7] * inv - u0[7]);
        const bf16x8 bfrag = __builtin_bit_cast(bf16x8, bw);
        asm volatile("" : "+v"(afr[0]), "+v"(afr[1]), "+v"(afr[2]), "+v"(afr[3]), "+v"(afr[4]), "+v"(afr[5]), "+v"(afr[6]), "+v"(afr[7]),
                          "+v"(afr[8]), "+v"(afr[9]), "+v"(afr[10]), "+v"(afr[11]), "+v"(afr[12]), "+v"(afr[13]), "+v"(afr[14]), "+v"(afr[15]));
#pragma unroll
        for (int db = 0; db < 16; ++db) acc[db] = __builtin_amdgcn_mfma_f32_16x16x32_bf16(afr[db], bfrag, acc[db], 0, 0, 0);
    }
    bf16* yo = y + (size_t)t * DM + 2 * GW + g * 256 + 4 * kq;
    const float* psc = pscale + g * 256 + 4 * kq;
    f32x4 sc4[16];
#pragma unroll
    for (int db = 0; db < 16; ++db) sc4[db] = *(const GAS f32x4*)(psc + db * 16);
#pragma unroll
    for (int db = 0; db < 16; ++db) { v2u ww; ww.x = cvtpk(acc[db][0] * sc4[db].x, acc[db][1] * sc4[db].y); ww.y = cvtpk(acc[db][2] * sc4[db].z, acc[db][3] * sc4[db].w);
        *(GAS v2u*)(yo + db * 16) = ww; }
    __syncthreads();
}
__device__ __forceinline__ void pool_item(const bf16* __restrict__ proj, const bf16* __restrict__ wpt, const float* __restrict__ pscale, bf16* __restrict__ y, int g, int tt, LAS char* lds) {
    if (g == 0) pool_item_w<2>(proj, wpt, pscale, y, g, tt, lds); else if (g == 1) pool_item_w<4>(proj, wpt, pscale, y, g, tt, lds);
    else if (g == 2) pool_item_w<8>(proj, wpt, pscale, y, g, tt, lds); else pool_item_w<16>(proj, wpt, pscale, y, g, tt, lds);
}
}

#ifdef SKIP_ATT0
#define ATT0(...)
#else
#define ATT0(...) __VA_ARGS__
#endif
#ifdef SKIP_ATT1
#define ATT1(...)
#else
#define ATT1(...) __VA_ARGS__
#endif
#ifdef SKIP_ATT2
#define ATT2(...)
#else
#define ATT2(...) __VA_ARGS__
#endif
#ifdef SKIP_POOL
#define POOL(...)
#else
#define POOL(...) __VA_ARGS__
#endif
#ifdef SKIP_GEMM1
#define GEMM1(...)
#else
#define GEMM1(...) __VA_ARGS__
#endif
#ifdef SKIP_GEMM2
#define GEMM2(...)
#else
#define GEMM2(...) __VA_ARGS__
#endif
#ifdef SKIP_GEMM3
#define GEMM3(...)
#else
#define GEMM3(...) __VA_ARGS__
#endif

constexpr int NPHASE = 2 + 8 * DEPTH;
struct Args { const float* in[13]; float* out; unsigned char* ws; int ph_lo, ph_hi, sub, pad; };
static_assert(sizeof(Args) == 136, "Args has no padding bytes");

typedef const __attribute__((address_space(4))) Args* KArgs;
__device__ __forceinline__ KArgs kargs() { KArgs p = (KArgs)__builtin_amdgcn_kernarg_segment_ptr(); asm volatile("" : "+s"(p)); return p; }
__device__ __forceinline__ int vcu_of(int G) { const int bx = blockIdx.x; return (G % 8 == 0) ? (bx % 8) * (G / 8) + bx / 8 : bx; }
template <int SP>
__device__ __forceinline__ void p0_work(const KArgs A, unsigned char* const ws, LAS unsigned char* lds, int lane, int wave, int gw, int NGW, int tid_) {
    if (SP == 0) {
        constexpr int SG_IN = 8192 / 256, SG_OUT = DM / 256, SG_G = DFF / 256, SG_D = DM / 256, SG_LAYER = SG_IN + SG_OUT + 2 * SG_G + SG_D;
        static_assert(DFF % 256 == 0 && DM % 256 == 0, "sample strides");
#pragma unroll 1
        for (int it = gw; it < DEPTH * SG_LAYER * 4; it += NGW) { const int q = it & 3; int g = it >> 2; const int l = g / SG_LAYER; g -= l * SG_LAYER; const int n = 4 * lane;
            if (g < SG_IN) { p0_sample_item(A->in[2] + (size_t)l * DM * INW + 2048, DM, INW, g * 256 + n, q, (unsigned*)(ws + WS_CMAX_IN) + (size_t)l * 8192, 8192, 0, 0); continue; } g -= SG_IN;
            if (g < SG_OUT) { p0_sample_item(A->in[6] + (size_t)l * DM * DM, DM, DM, g * 256 + n, q, (unsigned*)(ws + WS_CMAX_OUT) + (size_t)l * DM, DM, 0, 0); continue; } g -= SG_OUT;
            if (g < SG_G) { p0_sample_item(A->in[9] + (size_t)l * DM * DFF, DM, DFF, g * 256 + n, q, (unsigned*)(ws + WS_CMAX) + (size_t)l * NGU, 128, 256, 0); continue; } g -= SG_G;
            if (g < SG_G) { p0_sample_item(A->in[10] + (size_t)l * DM * DFF, DM, DFF, g * 256 + n, q, (unsigned*)(ws + WS_CMAX) + (size_t)l * NGU, 128, 256, 128); continue; } g -= SG_G;
            p0_sample_item(A->in[11] + (size_t)l * DFF * DM, DFF, DM, g * 256 + n, q, (unsigned*)(ws + WS_CMAX_DN) + (size_t)l * DM, DM, 0, 0); }
    } else {
        LAS float* scr = (LAS float*)(lds + RING_OFF + wave * 16384);
        constexpr int C_INB = 16 * (2048 / 64), C_IN8 = 16 * (8192 / 64), C_OUT = 16 * (DM / 64), C_G = 16 * (DFF / 64), C_D = 43 * (DM / 64), C_P = 4 * (256 / 64);
        constexpr int C_LAYER = C_INB + C_IN8 + C_OUT + 2 * C_G + C_D + C_P, C_HEAD = C_INB + C_IN8 + C_OUT;
        auto desc = [&](int it, int kt) -> TDesc {
            const int l = it / C_LAYER; int r = it - l * C_LAYER;
            unsigned char* wl = ws + WS_W + (size_t)l * W_LAYER;
            if (r < C_INB) return p0_tile_desc(A->in[2] + (size_t)l * DM * INW, DM, INW, 2048, wl + W_IN, 0, 2048, 0, 0, r, 4, kt, nullptr); r -= C_INB;
            if (r < C_IN8) return p0_tile_desc(A->in[2] + (size_t)l * DM * INW + 2048, DM, INW, 8192, wl + W_IN8, 1, 8192, 0, 0, r, 4, kt, (const unsigned*)(ws + WS_CMAX_IN) + (size_t)l * 8192); r -= C_IN8;
            if (r < C_OUT) return p0_tile_desc(A->in[6] + (size_t)l * DM * DM, DM, DM, DM, wl + W_OUT, 1, DM, 0, 0, r, 4, kt, (const unsigned*)(ws + WS_CMAX_OUT) + (size_t)l * DM); r -= C_OUT;
            if (r < C_G) return p0_tile_desc(A->in[9] + (size_t)l * DM * DFF, DM, DFF, DFF, wl + W_GU, 1, 128, 256, 0, r, 4, kt, (const unsigned*)(ws + WS_CMAX) + (size_t)l * NGU); r -= C_G;
            if (r < C_G) return p0_tile_desc(A->in[10] + (size_t)l * DM * DFF, DM, DFF, DFF, wl + W_GU, 1, 128, 256, 128, r, 4, kt, (const unsigned*)(ws + WS_CMAX) + (size_t)l * NGU); r -= C_G;
            if (r < C_D) return p0_tile_desc(A->in[11] + (size_t)l * DFF * DM, DFF, DM, DM, wl + W_DN, 2, DM, 0, 0, r, 4, kt, (const unsigned*)(ws + WS_CMAX_DN) + (size_t)l * DM); r -= C_D;
            const int g = r / 4, rr = r - g * 4;
            return p0_tile_desc(A->in[3] + (size_t)(l * 4 + g) * 256 * 256, 256, 256, 256, ws + WS_WP + (size_t)(l * 4 + g) * 256 * 256 * 2, 0, 256, 0, 0, rr, 4, kt, nullptr);
        };
        auto ntile = [&](int it) -> int { (void)it; return 4; };
        { constexpr int NIT = DEPTH * C_LAYER;
            auto gidx = [&](int j) -> int { return NIT - 1 - j; };
            int it = gw, kt = 0, nk = 0; f32x2_t va[32], vb[32]; float inv[8] = {0.f, 0.f, 0.f, 0.f, 0.f, 0.f, 0.f, 0.f}, invn[8] = {0.f, 0.f, 0.f, 0.f, 0.f, 0.f, 0.f, 0.f}; TDesc da, db;
            if (it < NIT) { nk = ntile(gidx(it)); da = desc(gidx(it), 0); p0_scale_load(da, inv, lane); p0_tile_load(da, va, lane); }
            while (it < NIT) {
                int itn = it, ktn = kt + 1, nkn = nk; if (ktn == nk) { itn = it + NGW; ktn = 0; if (itn < NIT) nkn = ntile(gidx(itn)); }
                if (itn < NIT) { db = desc(gidx(itn), ktn); if (itn != it) p0_scale_load(db, invn, lane); p0_tile_load(db, vb, lane); }
                p0_tile_store(da, va, scr, lane, inv); if (itn != it) { _Pragma("unroll") for (int e = 0; e < 8; ++e) inv[e] = invn[e]; }
                it = itn; kt = ktn; nk = nkn; if (it >= NIT) break;
                itn = it; ktn = kt + 1; nkn = nk; if (ktn == nk) { itn = it + NGW; ktn = 0; if (itn < NIT) nkn = ntile(gidx(itn)); }
                if (itn < NIT) { da = desc(gidx(itn), ktn); if (itn != it) p0_scale_load(da, invn, lane); p0_tile_load(da, va, lane); }
                p0_tile_store(db, vb, scr, lane, inv); if (itn != it) { _Pragma("unroll") for (int e = 0; e < 8; ++e) inv[e] = invn[e]; }
                it = itn; kt = ktn; nk = nkn; } }
        { LAS float* gl = (LAS float*)(lds + RING_OFF); __syncthreads(); stage_gains(gl, A->in[1], nullptr, tid_);
          _Pragma("unroll 1") for (int m = gw; m < M; m += NGW) rms_row_to_bf16(A->in[0] + (size_t)m * DM, gl, (bf16*)(ws + WS_H) + (size_t)m * DM, ws + WS_H8 + (size_t)m * DM, (float*)(ws + WS_HS) + m, lane); }
    }
}
__global__ void __launch_bounds__(NWAVES * 64, 2) hybrid_fwd(Args args_unused) {
    extern __shared__ __attribute__((aligned(16))) unsigned char lds_raw[];
    LAS unsigned char* lds = (LAS unsigned char*)lds_raw;
    for (int u = threadIdx.x; u < (LDS_BYTES - LDSCTL_OFF) / 4; u += NWAVES * 64) ((LAS unsigned*)(lds + LDSCTL_OFF))[u] = 0u;
    __syncthreads();
    if (MK_N_LAUNCHES == 1) (void)xcd_barrier_post((unsigned*)((gu32*)(kargs()->ws + WS_CTL) + CW_BAR), (volatile LAS unsigned*)(lds + MISC_OFF) + 8);
#define GRID_BAR() do { if (MK_N_LAUNCHES == 1) { XcdBarrier bar_; bar_.bar = (unsigned*)((gu32*)(kargs()->ws + WS_CTL) + CW_BAR); bar_.x = xb_xcc_id(); bar_.st = (volatile LAS unsigned*)(lds + MISC_OFF) + 8; xcd_barrier(bar_); } } while (0)
#define IN(k) (A->ph_lo <= (k) && (k) < A->ph_hi)
#define BOTH(k) (IN(k) && IN((k) + 1))
#define PHASE_ENV() const KArgs A = kargs(); unsigned char* const ws = A->ws; int tid_ = threadIdx.x; asm volatile("" : "+v"(tid_)); const int lane = tid_ & 63, wave = __builtin_amdgcn_readfirstlane(tid_ >> 6); const int G = gridDim.x, vcu = vcu_of(G); \
    const int gw = vcu * NWAVES + wave, NGW = G * NWAVES; (void)lane; (void)gw; (void)NGW; (void)ws

    { PHASE_ENV(); if (IN(0)) { p0_work<0>(A, ws, lds, lane, wave, gw, NGW, tid_); if (BOTH(0)) GRID_BAR(); } }
    { PHASE_ENV(); if (IN(1)) { p0_work<1>(A, ws, lds, lane, wave, gw, NGW, tid_); if (BOTH(1)) GRID_BAR(); } }

    for (int l = 0; l < DEPTH; ++l) {
        const int pb = 2 + 8 * l;
        { PHASE_ENV();
        if (IN(pb + 0)) {
            { pg8::Gemm g{(const bf16*)(ws + WS_H), (const bf16*)(ws + WS_W + (size_t)l * W_LAYER + W_IN), M, 2048, DM}; pg8::StaticOrder S; S.init(M, 2048, G, (int)blockIdx.x);
              pg8::EpiProj E{(bf16*)(ws + WS_PROJ), INW, (float*)(ws + WS_KSUM) + (size_t)l * 32 * 1024};
              GEMM1(pg8::gemm_phase<pg8::EpiProj, pg8::StaticOrder, true, true>(lds + RING_OFF, g, S, E);) }
            { pg8::Gemm g{(const bf16*)(ws + WS_H8), (const bf16*)(ws + WS_W + (size_t)l * W_LAYER + W_IN8), M, 8192, DM / 2}; pg8::StaticOrder S; S.init(M, 8192, G, (int)blockIdx.x);
              pg8::EpiProj8 E{(bf16*)(ws + WS_PROJ), INW, 2048, (const float*)(ws + WS_HS), (const float*)(ws + WS_CMAX_IN) + (size_t)l * 8192};
              GEMM1(pg8::gemm_phase<pg8::EpiProj8, pg8::StaticOrder, false, true, 1>(lds + RING_OFF, g, S, E);) }
            if (BOTH(pb + 0)) GRID_BAR();
        } }
        { PHASE_ENV();
        if (IN(pb + 1)) {
            LAS char* alds = (LAS char*)(lds + RING_OFF);
            const bf16* PROJ = (const bf16*)(ws + WS_PROJ); bf16* Yb = (bf16*)(ws + WS_Y); const float* ksum = (const float*)(ws + WS_KSUM) + (size_t)l * 32 * 1024;
            for (int w = vcu; w < 256; w += G) {
                const int idx = w & 127, bh = idx >> 2, p = idx & 3;
                const int sub = A->sub;
                ATT0(if (w < 128 && (sub & 1)) { for (int ps = 0; ps < 2; ++ps) att::attn_block<0>(PROJ, Yb, ksum, bh >> 3, bh & 7, ps ? p : 7 - p, alds); })
                ATT1(if (w >= 128 && (sub & 2)) { for (int ps = 0; ps < 2; ++ps) att::attn_block<1>(PROJ, Yb, ksum, bh >> 3, bh & 7, ps ? p : 7 - p, alds); })
                ATT2(if (sub & 4) { const int bh2 = w >> 3; att::attn_block<2>(PROJ, Yb, ksum, bh2 >> 3, bh2 & 7, w & 7, alds); })
                POOL(if (sub & 8) att::pool_item(PROJ, (const bf16*)(ws + WS_WP) + (size_t)l * 4 * 256 * 256, A->in[4] + (size_t)l * GW, Yb, w >> 6, w & 63, alds);)
            }
            if (BOTH(pb + 1)) GRID_BAR();
        } }
        { PHASE_ENV();
        if (IN(pb + 2)) {
            LAS float* gl = (LAS float*)(lds + RING_OFF); stage_gains(gl, A->in[5] + (size_t)l * DM, nullptr, tid_);
            _Pragma("unroll 1") for (int m = gw; m < M; m += NGW) mixnorm_row((const bf16*)(ws + WS_Y) + (size_t)m * DM, gl, ws + WS_YN + (size_t)m * DM, (float*)(ws + WS_YS) + m, lane);
            if (BOTH(pb + 2)) GRID_BAR();
        } }
        { PHASE_ENV();
        if (IN(pb + 3)) {
            pg8::Gemm g{(const bf16*)(ws + WS_YN), (const bf16*)(ws + WS_W + (size_t)l * W_LAYER + W_OUT), M, DM, DM / 2}; pg8::StaticOrder S; S.init(M, DM, G, (int)blockIdx.x);
            pg8::EpiF32S E{(bf16*)(ws + WS_MF), DM, (const float*)(ws + WS_YS), (const float*)(ws + WS_CMAX_OUT) + (size_t)l * DM};
            GEMM2(pg8::gemm_phase<pg8::EpiF32S, pg8::StaticOrder, false, true, 1>(lds + RING_OFF, g, S, E);)
            if (BOTH(pb + 3)) GRID_BAR();
        } }
        { PHASE_ENV();
        if (IN(pb + 4)) {
            bf16* XS = (bf16*)(ws + WS_XS); LAS float* gl = (LAS float*)(lds + RING_OFF);
            stage_gains(gl, A->in[7] + (size_t)l * DM, A->in[8] + (size_t)l * DM, tid_);
            if (l == 0) { _Pragma("unroll 1") for (int m = gw; m < M; m += NGW) resid_row<true, false, true>((const bf16*)(ws + WS_MF) + (size_t)m * DM, A->in[0] + (size_t)m * DM, gl, XS + (size_t)m * DM, nullptr, ws + WS_H8 + (size_t)m * DM, (float*)(ws + WS_HS) + m, lane); }
            else { _Pragma("unroll 1") for (int m = gw; m < M; m += NGW) resid_row<false, false, true>((const bf16*)(ws + WS_MF) + (size_t)m * DM, XS + (size_t)m * DM, gl, XS + (size_t)m * DM, nullptr, ws + WS_H8 + (size_t)m * DM, (float*)(ws + WS_HS) + m, lane); }
            if (BOTH(pb + 4)) GRID_BAR();
        } }
        { PHASE_ENV();
        if (IN(pb + 5)) {
            pg8::Gemm g{(const bf16*)(ws + WS_H8), (const bf16*)(ws + WS_W + (size_t)l * W_LAYER + W_GU), M, NGU, DM / 2}; pg8::StaticOrder S; S.init(M, NGU, G, (int)blockIdx.x);
            pg8::EpiSwiGLU8 E{ws + WS_ACT, DFF, (const float*)(ws + WS_HS), (const float*)(ws + WS_CMAX) + (size_t)l * NGU};
            GEMM3(pg8::gemm_phase<pg8::EpiSwiGLU8, pg8::StaticOrder, false, true, 1>(lds + RING_OFF, g, S, E);)
            if (BOTH(pb + 5)) GRID_BAR();
        } }
        { PHASE_ENV();
        if (IN(pb + 6)) {
            pg8::Gemm g{(const bf16*)(ws + WS_ACT), (const bf16*)(ws + WS_W + (size_t)l * W_LAYER + W_DN), M, DM, DFF / 2}; pg8::StaticOrder S; S.init(M, DM, G, (int)blockIdx.x);
            pg8::EpiF32C E{(bf16*)(ws + WS_MF), DM, (const float*)(ws + WS_CMAX_DN) + (size_t)l * DM};
            GEMM2(pg8::gemm_phase<pg8::EpiF32C, pg8::StaticOrder, false, true, 2>(lds + RING_OFF, g, S, E);)
            if (BOTH(pb + 6)) GRID_BAR();
        } }
        { PHASE_ENV();
        if (IN(pb + 7)) {
            bf16* XS = (bf16*)(ws + WS_XS); LAS float* gl = (LAS float*)(lds + RING_OFF);
            stage_gains(gl, A->in[12] + (size_t)l * DM, (l + 1 < DEPTH) ? A->in[1] + (size_t)(l + 1) * DM : nullptr, tid_);
            if (l + 1 < DEPTH) { _Pragma("unroll 1") for (int m = gw; m < M; m += NGW) resid_row<false, false, true>((const bf16*)(ws + WS_MF) + (size_t)m * DM, XS + (size_t)m * DM, gl, XS + (size_t)m * DM, (bf16*)(ws + WS_H) + (size_t)m * DM, ws + WS_H8 + (size_t)m * DM, (float*)(ws + WS_HS) + m, lane); }
            else { _Pragma("unroll 1") for (int m = gw; m < M; m += NGW) resid_row<false, true, false>((const bf16*)(ws + WS_MF) + (size_t)m * DM, XS + (size_t)m * DM, gl, A->out + (size_t)m * DM, nullptr, nullptr, nullptr, lane); }
            if (BOTH(pb + 7)) GRID_BAR();
        } }
    }
#undef IN
#undef BOTH
#undef GRID_BAR
#undef PHASE_ENV
}

#ifndef PROBE_DUP_MASK
#define PROBE_DUP_MASK 0ull
#endif
#ifndef PROBE_EXTRA
#define PROBE_EXTRA 1
#endif
#ifndef PROBE_SUB
#define PROBE_SUB 0
#endif
#ifndef PROBE_PAIR01
#define PROBE_PAIR01 0
#endif
extern "C" void kernel_launch(void* const* d_in, const int* in_sizes, int n_in, void* d_out, int out_size, void* d_ws, size_t ws_size, hipStream_t stream) {
    static int grid = 0;
    if (grid == 0) {
        if (n_in != 13 || in_sizes[0] != M * DM || out_size != M * DM || ws_size < WS_END) { fprintf(stderr, "kernel_launch: shape/workspace mismatch (n_in %d, in0 %d, out %d, ws %zu, need %zu); nothing launched\n", n_in, n_in > 0 ? in_sizes[0] : -1, out_size, ws_size, (size_t)WS_END); grid = -1; return; }
        int dev = 0, cus = 0, per_cu = 0;
        if (hipGetDevice(&dev) != hipSuccess || hipDeviceGetAttribute(&cus, hipDeviceAttributeMultiprocessorCount, dev) != hipSuccess) { fprintf(stderr, "kernel_launch: device query failed\n"); grid = -1; return; }
        if (hipFuncSetAttribute((const void*)hybrid_fwd, hipFuncAttributeMaxDynamicSharedMemorySize, LDS_BYTES) != hipSuccess) { fprintf(stderr, "kernel_launch: hipFuncSetAttribute failed\n"); grid = -1; return; }
        if (hipOccupancyMaxActiveBlocksPerMultiprocessor(&per_cu, (const void*)hybrid_fwd, NWAVES * 64, LDS_BYTES) != hipSuccess || per_cu < 1)
            fprintf(stderr, "kernel_launch: note: the occupancy query reports %d workgroups per CU\n", per_cu);
        (void)hipGetLastError();
        grid = cus;
    }
    if (grid < 0) return;
    if (hipMemsetAsync((char*)d_ws + WS_CTL, 0, CTL_ZERO_BYTES, stream) != hipSuccess) { fprintf(stderr, "kernel_launch: hipMemsetAsync failed\n"); return; }
    Args a{};
    for (int i = 0; i < 13; ++i) a.in[i] = (const float*)d_in[i];
    a.out = (float*)d_out; a.ws = (unsigned char*)d_ws; a.sub = 15; a.pad = 0;
    if (MK_N_LAUNCHES == 1) {
        a.ph_lo = 0; a.ph_hi = NPHASE;
        hipLaunchKernelGGL(hybrid_fwd, dim3(grid), dim3(NWAVES * 64), LDS_BYTES, stream, a);
    } else {
        for (int k = 0; k < NPHASE; ++k) { a.ph_lo = k; a.ph_hi = k + 1; const int reps = 1 + (int)((PROBE_DUP_MASK >> k) & 1ull) * PROBE_EXTRA;
            for (int r = 0; r < reps; ++r) hipLaunchKernelGGL(hybrid_fwd, dim3(grid), dim3(NWAVES * 64), LDS_BYTES, stream, a);
            if (PROBE_PAIR01 && k == 1) { for (int r = 0; r < PROBE_EXTRA; ++r) for (int k2 = 0; k2 < 2; ++k2) { a.ph_lo = k2; a.ph_hi = k2 + 1; hipLaunchKernelGGL(hybrid_fwd, dim3(grid), dim3(NWAVES * 64), LDS_BYTES, stream, a); } a.ph_lo = k; a.ph_hi = k + 1; }
            if (PROBE_SUB && k == 3) { a.sub = PROBE_SUB; for (int r = 0; r < PROBE_EXTRA; ++r) hipLaunchKernelGGL(hybrid_fwd, dim3(grid), dim3(NWAVES * 64), LDS_BYTES, stream, a); a.sub = 15; } }
    }
    const hipError_t le = hipPeekAtLastError();
    if (le != hipSuccess) fprintf(stderr, "kernel_launch: launch failed: %s\n", hipGetErrorName(le));
}
```

```cpp
#include <hip/hip_runtime.h>
#include <cstdio>
#include <cstdint>
#ifndef MK_N_LAUNCHES
#define MK_N_LAUNCHES 1
#endif
namespace pg8 {
#define PG8_LAS __attribute__((address_space(3)))
typedef unsigned short bf16_t;
typedef short bf16x8 __attribute__((ext_vector_type(8)));
typedef float f32x4 __attribute__((ext_vector_type(4)));
typedef unsigned u32x4 __attribute__((ext_vector_type(4)));
typedef int i32x4 __attribute__((ext_vector_type(4)));
typedef int i32x8 __attribute__((ext_vector_type(8)));
constexpr int BM = 256, BK = 64, HALF = 128, HTB = HALF * BK * 2  , STAGE_BYTES = 8 * HTB, NXCD = 8, WGM = 8;

__host__ __device__ __forceinline__ int lds_byte(int r, int c) { const int st = (r >> 4) * 2 + (c >> 5), rr = r & 15, cc = c & 31, ob = rr * 64 + cc * 2; return st * 1024 + (ob ^ (((ob >> 9) & 1) << 5)); }
__host__ __device__ __forceinline__ void stage_rc(int b, int& R, int& C) { const int st = b / 1024, sb = b % 1024, swz = sb ^ (((sb >> 9) & 1) << 5); R = (st >> 1) * 16 + swz / 64; C = (st & 1) * 32 + (swz % 64) / 2; }
__host__ __device__ __forceinline__ int perm32(int rho) { const int n = rho >> 4, i = rho & 15; return 8 * (i >> 2) + 4 * n + (i & 3); }

struct Unit { int pm, pn; };
struct Gemm { const bf16_t* A; const bf16_t* Bt; int M, N, K; };

struct StaticOrder {
    int nM, nN, nwg, G, c;
    __host__ __device__ void init(int M, int N, int G_, int c_) { nM = M / BM; nN = N / BM; nwg = nM * nN; G = G_; c = c_; }
    __host__ __device__ bool next(int i, Unit& u) const {
        const long L = (long)i * G + c; if (L >= nwg) return false;
        int wgid = (int)L; { const int q = nwg / NXCD, r = nwg % NXCD, xcd = wgid % NXCD, off = wgid / NXCD; wgid = (xcd < r ? xcd * (q + 1) : r * (q + 1) + (xcd - r) * q) + off; }
        const int nig = WGM * nN, gid = wgid / nig, fm = gid * WGM, gsz = (nM - fm) < WGM ? (nM - fm) : WGM;
        u.pm = fm + ((wgid % nig) % gsz); u.pn = (wgid % nig) / gsz; return true;
    }
    __device__ __forceinline__ void a_ready(const Unit&) const {}
    __device__ __forceinline__ void done(const Unit&) const {}
};

typedef unsigned u32x2 __attribute__((ext_vector_type(2)));
typedef float f32x2_cv __attribute__((ext_vector_type(2))); typedef __bf16 bf16x2_cv __attribute__((ext_vector_type(2)));
__device__ __forceinline__ unsigned cvt_pk_bf16(float lo, float hi) { const f32x2_cv v = {lo, hi}; return __builtin_bit_cast(unsigned, __builtin_convertvector(v, bf16x2_cv)); }

__device__ __forceinline__ float ld_f32_asm(const float* p) { float r; asm volatile("global_load_dword %0, %1, off" : "=&v"(r) : "v"(p) : "memory"); return r; }
__device__ __forceinline__ f32x4 ld_f32x4_asm(const float* p) { f32x4 r; asm volatile("global_load_dwordx4 %0, %1, off" : "=&v"(r) : "v"(p) : "memory"); return r; }
#define PG8_WAIT_SCALES(c0, c1, c2, c3, rsv) asm volatile("s_waitcnt vmcnt(0)" : "+v"(c0), "+v"(c1), "+v"(c2), "+v"(c3), "+v"(rsv[0][0]), "+v"(rsv[0][1]), "+v"(rsv[0][2]), "+v"(rsv[0][3]), "+v"(rsv[1][0]), "+v"(rsv[1][1]), "+v"(rsv[1][2]), "+v"(rsv[1][3]) :: "memory")
__device__ __forceinline__ void st16_wt(void* p, u32x4 w) { asm volatile("global_store_dwordx4 %0, %1, off sc1\n\ts_nop 1" :: "v"(p), "v"(w) : "memory"); }
struct EpiProj {
    static constexpr bool PERM = true, AFTER_DRAIN = false;
    bf16_t* O; int ldc; float* ksum;
    __device__ __forceinline__ void operator()(const f32x4 (&acc)[2][2][4][2], const Unit& u, int wr, int wc, int fr, int fq) const {
        const int row0 = u.pm * BM + wr * 64 + fr, col0 = u.pn * BM + wc * 32 + 8 * fq;
#pragma unroll
        for (int ai = 0; ai < 2; ++ai)
#pragma unroll
            for (int m = 0; m < 4; ++m) { bf16_t* rowp = O + (size_t)(row0 + ai * HALF + m * 16) * ldc + col0;
#pragma unroll
                for (int bj = 0; bj < 2; ++bj) { const f32x4 v0 = acc[ai][bj][m][0], v1 = acc[ai][bj][m][1];
                    u32x4 w; w.x = cvt_pk_bf16(v0[0], v0[1]); w.y = cvt_pk_bf16(v0[2], v0[3]); w.z = cvt_pk_bf16(v1[0], v1[1]); w.w = cvt_pk_bf16(v1[2], v1[3]);
                    st16_wt(rowp + bj * HALF, w); } }
        if (u.pn >= 4 && u.pn < 8) {
#pragma unroll
            for (int bj = 0; bj < 2; ++bj)
#pragma unroll
                for (int n = 0; n < 2; ++n) { f32x4 s = (f32x4){0.f, 0.f, 0.f, 0.f};
#pragma unroll
                    for (int ai = 0; ai < 2; ++ai)
#pragma unroll
                        for (int m = 0; m < 4; ++m) s += acc[ai][bj][m][n];
#pragma unroll
                    for (int o = 1; o < 16; o <<= 1) { s[0] += __shfl_xor(s[0], o); s[1] += __shfl_xor(s[1], o); s[2] += __shfl_xor(s[2], o); s[3] += __shfl_xor(s[3], o); }
                    if (fr == 0) { float* kp = ksum + (size_t)u.pm * 1024 + (u.pn - 4) * BM + bj * HALF + wc * 32 + 8 * fq + 4 * n;
#pragma unroll
                        for (int j = 0; j < 4; ++j) (void)__hip_atomic_fetch_add(kp + j, s[j], __ATOMIC_RELAXED, __HIP_MEMORY_SCOPE_AGENT); } }
        }
    }
};
struct EpiF32 {
    static constexpr bool PERM = false, AFTER_DRAIN = false;
    float* C; int ldc;
    __device__ __forceinline__ void operator()(const f32x4 (&acc)[2][2][4][2], const Unit& u, int wr, int wc, int fr, int fq) const {
        const int row0 = u.pm * BM + wr * 64 + fr, col0 = u.pn * BM + wc * 32 + 4 * fq;
#pragma unroll
        for (int ai = 0; ai < 2; ++ai)
#pragma unroll
            for (int m = 0; m < 4; ++m) { float* rowp = C + (size_t)(row0 + ai * HALF + m * 16) * ldc + col0;
#pragma unroll
                for (int bj = 0; bj < 2; ++bj)
#pragma unroll
                    for (int n = 0; n < 2; ++n) *(f32x4*)(rowp + bj * HALF + n * 16) = acc[ai][bj][m][n]; }
    }
};
struct EpiSwiGLU {
    static constexpr bool PERM = true, AFTER_DRAIN = false;
    bf16_t* O; int ldc;
    static __device__ __forceinline__ float silu_mul(float g, float up) { return g * up * __builtin_amdgcn_rcpf(1.0f + __builtin_amdgcn_exp2f(g * -1.4426950408889634f)); }
    __device__ __forceinline__ void operator()(const f32x4 (&acc)[2][2][4][2], const Unit& u, int wr, int wc, int fr, int fq) const {
        const int row0 = u.pm * BM + wr * 64 + fr, col0 = u.pn * HALF + wc * 32 + 8 * fq;
#pragma unroll
        for (int ai = 0; ai < 2; ++ai)
#pragma unroll
            for (int m = 0; m < 4; ++m) { bf16_t* rowp = O + (size_t)(row0 + ai * HALF + m * 16) * ldc + col0;
                const f32x4 g0 = acc[ai][0][m][0], g1 = acc[ai][0][m][1], u0 = acc[ai][1][m][0], u1 = acc[ai][1][m][1];
                u32x4 w; w.x = cvt_pk_bf16(silu_mul(g0[0], u0[0]), silu_mul(g0[1], u0[1])); w.y = cvt_pk_bf16(silu_mul(g0[2], u0[2]), silu_mul(g0[3], u0[3]));
                w.z = cvt_pk_bf16(silu_mul(g1[0], u1[0]), silu_mul(g1[1], u1[1])); w.w = cvt_pk_bf16(silu_mul(g1[2], u1[2]), silu_mul(g1[3], u1[3]));
                st16_wt(rowp, w); }
    }
};
struct EpiSwiGLU8 {
    static constexpr bool PERM = true, AFTER_DRAIN = false;
    unsigned char* O; int ldc; const float* rs; const float* cs;
    __device__ __forceinline__ void operator()(const f32x4 (&acc)[2][2][4][2], const Unit& u, int wr, int wc, int fr, int fq) const {
        const int row0 = u.pm * BM + wr * 64 + fr, col0 = u.pn * HALF + wc * 32 + 8 * fq;
        const float* csp = cs + (size_t)u.pn * BM + wc * 32 + 8 * fq;
        f32x4 cg0 = ld_f32x4_asm(csp), cg1 = ld_f32x4_asm(csp + 4), cu0 = ld_f32x4_asm(csp + HALF), cu1 = ld_f32x4_asm(csp + HALF + 4);
        float rsv[2][4];
#pragma unroll
        for (int ai = 0; ai < 2; ++ai)
#pragma unroll
            for (int m = 0; m < 4; ++m) rsv[ai][m] = ld_f32_asm(rs + row0 + ai * HALF + m * 16);
        PG8_WAIT_SCALES(cg0, cg1, cu0, cu1, rsv);
#pragma unroll
        for (int ai = 0; ai < 2; ++ai)
#pragma unroll
            for (int m = 0; m < 4; ++m) { const int row = row0 + ai * HALF + m * 16; unsigned char* rowp = O + (size_t)row * ldc + col0; const float r = rsv[ai][m];
                const i32x4 ig0 = __builtin_bit_cast(i32x4, acc[ai][0][m][0]), ig1 = __builtin_bit_cast(i32x4, acc[ai][0][m][1]), iu0 = __builtin_bit_cast(i32x4, acc[ai][1][m][0]), iu1 = __builtin_bit_cast(i32x4, acc[ai][1][m][1]);
                f32x4 g0, g1, u0, u1;
#pragma unroll
                for (int j = 0; j < 4; ++j) { g0[j] = (float)ig0[j] * (r * cg0[j]); g1[j] = (float)ig1[j] * (r * cg1[j]); u0[j] = (float)iu0[j] * (r * cu0[j]); u1[j] = (float)iu1[j] * (r * cu1[j]); }
                int w0 = 0, w1 = 0;
                w0 = __builtin_amdgcn_cvt_pk_fp8_f32(EpiSwiGLU::silu_mul(g0[0], u0[0]), EpiSwiGLU::silu_mul(g0[1], u0[1]), w0, false); w0 = __builtin_amdgcn_cvt_pk_fp8_f32(EpiSwiGLU::silu_mul(g0[2], u0[2]), EpiSwiGLU::silu_mul(g0[3], u0[3]), w0, true);
                w1 = __builtin_amdgcn_cvt_pk_fp8_f32(EpiSwiGLU::silu_mul(g1[0], u1[0]), EpiSwiGLU::silu_mul(g1[1], u1[1]), w1, false); w1 = __builtin_amdgcn_cvt_pk_fp8_f32(EpiSwiGLU::silu_mul(g1[2], u1[2]), EpiSwiGLU::silu_mul(g1[3], u1[3]), w1, true);
                u32x2 w; w.x = (unsigned)w0; w.y = (unsigned)w1; *(u32x2*)rowp = w; }
    }
};
struct EpiProj8 {
    static constexpr bool PERM = true, AFTER_DRAIN = false;
    bf16_t* O; int ldc; int coff; const float* rs; const float* cs;
    __device__ __forceinline__ void operator()(const f32x4 (&acc)[2][2][4][2], const Unit& u, int wr, int wc, int fr, int fq) const {
        const int row0 = u.pm * BM + wr * 64 + fr, col0 = u.pn * BM + wc * 32 + 8 * fq;
        const float* csp = cs + col0;
        f32x4 c00 = ld_f32x4_asm(csp), c01 = ld_f32x4_asm(csp + 4), c10 = ld_f32x4_asm(csp + HALF), c11 = ld_f32x4_asm(csp + HALF + 4);
        float rsv[2][4];
#pragma unroll
        for (int ai = 0; ai < 2; ++ai)
#pragma unroll
            for (int m = 0; m < 4; ++m) rsv[ai][m] = ld_f32_asm(rs + row0 + ai * HALF + m * 16);
        PG8_WAIT_SCALES(c00, c01, c10, c11, rsv);
#pragma unroll
        for (int ai = 0; ai < 2; ++ai)
#pragma unroll
            for (int m = 0; m < 4; ++m) { const int row = row0 + ai * HALF + m * 16; bf16_t* rowp = O + (size_t)row * ldc + coff + col0; const float r = rsv[ai][m];
#pragma unroll
                for (int bj = 0; bj < 2; ++bj) { const i32x4 i0 = __builtin_bit_cast(i32x4, acc[ai][bj][m][0]), i1 = __builtin_bit_cast(i32x4, acc[ai][bj][m][1]);
                    const f32x4 ca = bj ? c10 : c00, cb = bj ? c11 : c01; f32x4 v0, v1;
#pragma unroll
                    for (int j = 0; j < 4; ++j) { v0[j] = (float)i0[j] * (r * ca[j]); v1[j] = (float)i1[j] * (r * cb[j]); }
                    u32x4 w; w.x = cvt_pk_bf16(v0[0], v0[1]); w.y = cvt_pk_bf16(v0[2], v0[3]); w.z = cvt_pk_bf16(v1[0], v1[1]); w.w = cvt_pk_bf16(v1[2], v1[3]);
                    st16_wt(rowp + bj * HALF, w); } }
    }
};
struct EpiF32S {
    static constexpr bool PERM = true, AFTER_DRAIN = false;
    bf16_t* C; int ldc; const float* rs; const float* cs;
    __device__ __forceinline__ void operator()(const f32x4 (&acc)[2][2][4][2], const Unit& u, int wr, int wc, int fr, int fq) const {
        const int row0 = u.pm * BM + wr * 64 + fr, col0 = u.pn * BM + wc * 32 + 8 * fq;
        f32x4 cv[2][2];
#pragma unroll
        for (int bj = 0; bj < 2; ++bj)
#pragma unroll
            for (int n = 0; n < 2; ++n) cv[bj][n] = ld_f32x4_asm(cs + col0 + bj * HALF + n * 4);
        float rsv[2][4];
#pragma unroll
        for (int ai = 0; ai < 2; ++ai)
#pragma unroll
            for (int m = 0; m < 4; ++m) rsv[ai][m] = ld_f32_asm(rs + row0 + ai * HALF + m * 16);
        PG8_WAIT_SCALES(cv[0][0], cv[0][1], cv[1][0], cv[1][1], rsv);
#pragma unroll
        for (int ai = 0; ai < 2; ++ai)
#pragma unroll
            for (int m = 0; m < 4; ++m) { const int row = row0 + ai * HALF + m * 16; bf16_t* rowp = C + (size_t)row * ldc + col0; const float r = rsv[ai][m];
#pragma unroll
                for (int bj = 0; bj < 2; ++bj) { const i32x4 i0 = __builtin_bit_cast(i32x4, acc[ai][bj][m][0]), i1 = __builtin_bit_cast(i32x4, acc[ai][bj][m][1]); f32x4 v0, v1;
#pragma unroll
                    for (int j = 0; j < 4; ++j) { v0[j] = (float)i0[j] * (r * cv[bj][0][j]); v1[j] = (float)i1[j] * (r * cv[bj][1][j]); }
                    u32x4 w; w.x = cvt_pk_bf16(v0[0], v0[1]); w.y = cvt_pk_bf16(v0[2], v0[3]); w.z = cvt_pk_bf16(v1[0], v1[1]); w.w = cvt_pk_bf16(v1[2], v1[3]);
                    st16_wt(rowp + bj * HALF, w); } }
    }
};
struct EpiF32C {
    static constexpr bool PERM = true, AFTER_DRAIN = false;
    bf16_t* C; int ldc; const float* cs;
    __device__ __forceinline__ void operator()(const f32x4 (&acc)[2][2][4][2], const Unit& u, int wr, int wc, int fr, int fq) const {
        const int row0 = u.pm * BM + wr * 64 + fr, col0 = u.pn * BM + wc * 32 + 8 * fq;
        f32x4 cv[2][2];
#pragma unroll
        for (int bj = 0; bj < 2; ++bj)
#pragma unroll
            for (int n = 0; n < 2; ++n) cv[bj][n] = ld_f32x4_asm(cs + col0 + bj * HALF + n * 4);
        asm volatile("s_waitcnt vmcnt(0)" : "+v"(cv[0][0]), "+v"(cv[0][1]), "+v"(cv[1][0]), "+v"(cv[1][1]) :: "memory");
#pragma unroll
        for (int bj = 0; bj < 2; ++bj)
#pragma unroll
            for (int n = 0; n < 2; ++n) cv[bj][n] *= (1.0f / 448.0f);
#pragma unroll
        for (int ai = 0; ai < 2; ++ai)
#pragma unroll
            for (int m = 0; m < 4; ++m) { bf16_t* rowp = C + (size_t)(row0 + ai * HALF + m * 16) * ldc + col0;
#pragma unroll
                for (int bj = 0; bj < 2; ++bj) { const f32x4 v0 = acc[ai][bj][m][0] * cv[bj][0], v1 = acc[ai][bj][m][1] * cv[bj][1];
                    u32x4 w; w.x = cvt_pk_bf16(v0[0], v0[1]); w.y = cvt_pk_bf16(v0[2], v0[3]); w.z = cvt_pk_bf16(v1[0], v1[1]); w.w = cvt_pk_bf16(v1[2], v1[3]);
                    st16_wt(rowp + bj * HALF, w); } }
    }
};

template <class Epi, class Sched, bool ALIGN_EPI = false, bool SP2 = false, int DT = 0>
__device__ __forceinline__ void gemm_phase(PG8_LAS unsigned char* lds, const Gemm g, const Sched& S, const Epi& E) {
    int tid = threadIdx.x; asm volatile("" : "+v"(tid));
    const int wid = __builtin_amdgcn_readfirstlane(tid >> 6), lane = tid & 63, wr = wid >> 2, wc = wid & 3, fr = lane & 15, fq = lane >> 4;
    const int K = g.K, nt = K / BK;
    unsigned voffA[2], voffB[2];
#pragma unroll
    for (int i = 0; i < 2; ++i) { int R, C; stage_rc(tid * 16 + i * 8192, R, C); const int Rb = Epi::PERM ? ((R & ~31) + perm32(R & 31)) : R;
        voffA[i] = (unsigned)(R * K + C) * 2u; voffB[i] = (unsigned)(Rb * K + C) * 2u; }
    const size_t kstep = (size_t)(BK * 2);
    const size_t hstep = (size_t)HALF * K * 2;
    const size_t tstep = 2 * hstep;
    const unsigned ldsw = (unsigned)wid * 1024u;
    const int aoff = lds_byte(wr * 64 + fr, fq * 8), boff = lds_byte(wc * 32 + fr, fq * 8);
#define PG8_SA(b, h) (((b) * 2 + (h)) * HTB)
#define PG8_SB(b, h) ((4 + (b) * 2 + (h)) * HTB)
#define PG8_STAGE(bufoff, gbase, voff) do { _Pragma("unroll") for (int _i = 0; _i < 2; ++_i) \
        __builtin_amdgcn_global_load_lds((const unsigned*)((const char*)(gbase) + (voff)[_i]), (PG8_LAS unsigned*)(lds + (bufoff) + ldsw + _i * 8192), 16, 0, 0); } while (0)
#define PG8_LDA(dst, b, h) do { _Pragma("unroll") for (int m = 0; m < 4; ++m) _Pragma("unroll") for (int k = 0; k < 2; ++k) dst[m][k] = *(const PG8_LAS bf16x8*)(lds + PG8_SA(b, h) + aoff + m * 2048 + k * 1024); } while (0)
#define PG8_LDB(dst, b, h) do { _Pragma("unroll") for (int n = 0; n < 2; ++n) _Pragma("unroll") for (int k = 0; k < 2; ++k) dst[n][k] = *(const PG8_LAS bf16x8*)(lds + PG8_SB(b, h) + boff + n * 2048 + k * 1024); } while (0)
#define PG8_MMA(ai, bj, At, Bt) do { __builtin_amdgcn_s_setprio(1); _Pragma("unroll") for (int m = 0; m < 4; ++m) _Pragma("unroll") for (int n = 0; n < 2; ++n) { \
        if constexpr (DT == 2) { const i32x4 b0_ = __builtin_bit_cast(i32x4, Bt[n][0]), b1_ = __builtin_bit_cast(i32x4, Bt[n][1]), a0_ = __builtin_bit_cast(i32x4, At[m][0]), a1_ = __builtin_bit_cast(i32x4, At[m][1]); \
            const i32x8 b8_ = (i32x8){b0_[0], b0_[1], b0_[2], b0_[3], b1_[0], b1_[1], b1_[2], b1_[3]}, a8_ = (i32x8){a0_[0], a0_[1], a0_[2], a0_[3], a1_[0], a1_[1], a1_[2], a1_[3]}; \
            asm volatile("v_mfma_scale_f32_16x16x128_f8f6f4 %0, %1, %2, %0, %3, %3 op_sel_hi:[0,0,0]" : "+v"(acc[ai][bj][m][n]) : "v"(b8_), "v"(a8_), "v"(f8scale)); } \
        else { _Pragma("unroll") for (int k = 0; k < 2; ++k) { \
        if constexpr (DT == 1) acc[ai][bj][m][n] = __builtin_bit_cast(f32x4, __builtin_amdgcn_mfma_i32_16x16x64_i8(__builtin_bit_cast(i32x4, Bt[n][k]), __builtin_bit_cast(i32x4, At[m][k]), __builtin_bit_cast(i32x4, acc[ai][bj][m][n]), 0, 0, 0)); \
        else acc[ai][bj][m][n] = __builtin_amdgcn_mfma_f32_16x16x32_bf16(Bt[n][k], At[m][k], acc[ai][bj][m][n], 0, 0, 0); } } } __builtin_amdgcn_s_setprio(0); } while (0)
#define PG8_WAIT_V(n) asm volatile("s_waitcnt vmcnt(" #n ")" ::: "memory")
#define PG8_WAIT_L(n) asm volatile("s_waitcnt lgkmcnt(" #n ")" ::: "memory")
#define PG8_BAR __builtin_amdgcn_s_barrier()
#define PG8_SCHED __builtin_amdgcn_sched_barrier(0)
    const int f8scale = 0x7f7f7f7f;
    Unit cur, nxt; int ui = 0;
    if (!S.next(0, cur)) return;
    f32x4 acc[2][2][4][2];
#pragma unroll
    for (int a = 0; a < 2; ++a)
#pragma unroll
        for (int b = 0; b < 2; ++b)
#pragma unroll
            for (int m = 0; m < 4; ++m)
#pragma unroll
                for (int n = 0; n < 2; ++n) acc[a][b][m][n] = (f32x4){0.f, 0.f, 0.f, 0.f};
    bf16x8 At[4][2], B0[2][2], B1[2][2];
    const char* cA = (const char*)g.A + (size_t)cur.pm * tstep; const char* cB = (const char*)g.Bt + (size_t)cur.pn * tstep;
    S.a_ready(cur);
    if constexpr (SP2) {
        PG8_STAGE(PG8_SB(0, 0), cB, voffB); PG8_STAGE(PG8_SB(0, 1), cB + hstep, voffB); PG8_STAGE(PG8_SA(0, 0), cA, voffA); PG8_STAGE(PG8_SA(0, 1), cA + hstep, voffA);
        if (wr == 1) PG8_BAR;
        PG8_WAIT_V(2); PG8_BAR;
        PG8_STAGE(PG8_SB(1, 0), cB + kstep, voffB); PG8_STAGE(PG8_SA(1, 0), cA + kstep, voffA); PG8_STAGE(PG8_SB(1, 1), cB + hstep + kstep, voffB);
        PG8_WAIT_V(6); PG8_BAR;
    } else {
        PG8_STAGE(PG8_SB(0, 0), cB, voffB); PG8_STAGE(PG8_SA(0, 0), cA, voffA); PG8_STAGE(PG8_SB(0, 1), cB + hstep, voffB); PG8_STAGE(PG8_SA(0, 1), cA + hstep, voffA);
        if (wr == 1) PG8_BAR;
        PG8_WAIT_V(4); PG8_BAR;
        PG8_STAGE(PG8_SB(1, 0), cB + kstep, voffB); PG8_STAGE(PG8_SA(1, 0), cA + kstep, voffA); PG8_STAGE(PG8_SB(1, 1), cB + hstep + kstep, voffB);
        PG8_WAIT_V(6); PG8_BAR;
    }
    for (;;) {
        const bool has_next = S.next(ui + 1, nxt);
        const char* nA = has_next ? (const char*)g.A + (size_t)nxt.pm * tstep : cA; const char* nB = has_next ? (const char*)g.Bt + (size_t)nxt.pn * tstep : cB;
        for (int t = 0; t < nt; t += 2) {
            const bool last = (t == nt - 2);
            const char* a1 = cA + (size_t)(t + 1) * kstep;
            const char* a2 = last ? nA : cA + (size_t)(t + 2) * kstep; const char* b2 = last ? nB : cB + (size_t)(t + 2) * kstep;
            const char* a3 = a2 + kstep; const char* b3 = b2 + kstep;
            if (last && has_next) S.a_ready(nxt);
            if constexpr (SP2) {
            PG8_LDB(B0, 0, 0); PG8_LDB(B1, 0, 1); PG8_SCHED; PG8_LDA(At, 0, 0); PG8_STAGE(PG8_SA(1, 1), a1 + hstep, voffA);
            PG8_WAIT_V(8); PG8_WAIT_L(0); PG8_BAR; PG8_MMA(0, 0, At, B0); PG8_MMA(0, 1, At, B1); PG8_BAR; PG8_SCHED;
            PG8_LDA(At, 0, 1); PG8_STAGE(PG8_SB(0, 0), b2, voffB); PG8_STAGE(PG8_SB(0, 1), b2 + hstep, voffB); PG8_STAGE(PG8_SA(0, 0), a2, voffA);
            PG8_WAIT_V(8); PG8_WAIT_L(0); PG8_BAR; PG8_MMA(1, 0, At, B0); PG8_MMA(1, 1, At, B1); PG8_BAR; PG8_SCHED;
            PG8_LDB(B0, 1, 0); PG8_LDB(B1, 1, 1); PG8_SCHED; PG8_LDA(At, 1, 0); PG8_STAGE(PG8_SA(0, 1), a2 + hstep, voffA);
            PG8_WAIT_V(8); PG8_WAIT_L(0); PG8_BAR; PG8_MMA(0, 0, At, B0); PG8_MMA(0, 1, At, B1); PG8_BAR; PG8_SCHED;
            PG8_LDA(At, 1, 1); PG8_STAGE(PG8_SB(1, 0), b3, voffB); PG8_STAGE(PG8_SB(1, 1), b3 + hstep, voffB); PG8_STAGE(PG8_SA(1, 0), a3, voffA);
            PG8_WAIT_V(8); PG8_WAIT_L(0); PG8_BAR; PG8_MMA(1, 0, At, B0); PG8_MMA(1, 1, At, B1); PG8_BAR; PG8_SCHED;
            } else {
            PG8_LDB(B0, 0, 0); PG8_SCHED; PG8_LDA(At, 0, 0); PG8_STAGE(PG8_SA(1, 1), a1 + hstep, voffA);
            PG8_WAIT_L(8); PG8_BAR; PG8_WAIT_L(0); PG8_MMA(0, 0, At, B0); PG8_BAR; PG8_SCHED;
            PG8_LDB(B1, 0, 1); PG8_STAGE(PG8_SB(0, 0), b2, voffB);
            PG8_BAR; PG8_WAIT_L(0); PG8_MMA(0, 1, At, B1); PG8_BAR;
            PG8_LDA(At, 0, 1); PG8_STAGE(PG8_SA(0, 0), a2, voffA);
            PG8_BAR; PG8_WAIT_L(0); PG8_MMA(1, 0, At, B0); PG8_BAR; PG8_SCHED;
            PG8_STAGE(PG8_SB(0, 1), b2 + hstep, voffB);
            PG8_WAIT_V(6); PG8_BAR; PG8_MMA(1, 1, At, B1); PG8_BAR;
            PG8_LDB(B0, 1, 0); PG8_SCHED; PG8_LDA(At, 1, 0); PG8_STAGE(PG8_SA(0, 1), a2 + hstep, voffA);
            PG8_WAIT_L(8); PG8_BAR; PG8_WAIT_L(0); PG8_MMA(0, 0, At, B0); PG8_BAR; PG8_SCHED;
            PG8_LDB(B1, 1, 1); PG8_STAGE(PG8_SB(1, 0), b3, voffB);
            PG8_BAR; PG8_WAIT_L(0); PG8_MMA(0, 1, At, B1); PG8_BAR;
            PG8_LDA(At, 1, 1); PG8_STAGE(PG8_SA(1, 0), a3, voffA);
            PG8_BAR; PG8_WAIT_L(0); PG8_MMA(1, 0, At, B0); PG8_BAR; PG8_SCHED;
            PG8_STAGE(PG8_SB(1, 1), b3 + hstep, voffB);
            PG8_WAIT_V(6); PG8_BAR; PG8_MMA(1, 1, At, B1); PG8_BAR;
            }
        }
        if constexpr (DT == 2) asm volatile("s_nop 15\n\ts_nop 15" ::: "memory");
        if constexpr (ALIGN_EPI) { if (wr == 0) PG8_BAR; }
        if constexpr (!Epi::AFTER_DRAIN) { E(acc, cur, wr, wc, fr, fq); S.done(cur); }
        if (!has_next) break;
#pragma unroll
        for (int a = 0; a < 2; ++a)
#pragma unroll
            for (int b = 0; b < 2; ++b)
#pragma unroll
                for (int m = 0; m < 4; ++m)
#pragma unroll
                    for (int n = 0; n < 2; ++n) acc[a][b][m][n] = (f32x4){0.f, 0.f, 0.f, 0.f};
        cur = nxt; cA = nA; cB = nB; ++ui;
        if constexpr (ALIGN_EPI) { if (wr == 1) PG8_BAR; }
    }
    PG8_WAIT_V(0);
    if constexpr (!ALIGN_EPI) { if (wr == 0) PG8_BAR; }
    PG8_BAR;
    if constexpr (Epi::AFTER_DRAIN) { E.fused(acc, cur, wr, wc, fr, fq, lds, wid, lane); S.done(cur); }
#undef PG8_SA
#undef PG8_SB
#undef PG8_STAGE
#undef PG8_LDA
#undef PG8_LDB
#undef PG8_MMA
#undef PG8_WAIT_V
#undef PG8_WAIT_L
#undef PG8_BAR
#undef PG8_SCHED
}
}

constexpr int BATCH = 4, SEQ = 2048, DM = 4096, DEPTH = 2, HD = 128, GW = 1024, NHEAD = 8, INW = 10240, DFF = 11008, NGU = 2 * DFF;
constexpr int M = BATCH * SEQ;
constexpr float RMS_EPS = 1e-6f;
constexpr int NWAVES = 8;

constexpr size_t MiB = 1u << 20;
constexpr size_t WS_CTL = 0, CTL_ZERO_BYTES = 2 * MiB;
constexpr size_t WS_CMAX = 1 * MiB + 512 * 1024;
constexpr size_t WS_CMAX_IN = WS_CMAX + 192 * 1024, WS_CMAX_OUT = WS_CMAX + 256 * 1024;
constexpr size_t WS_CMAX_DN = WS_CMAX + 320 * 1024;
constexpr size_t WS_KSUM = 1 * MiB;
constexpr size_t WS_W = 2 * MiB, W_LAYER = 370 * MiB;
constexpr size_t W_IN = 0  , W_IN8 = 16 * MiB  , W_OUT = 80 * MiB  , W_GU = 112 * MiB, W_DN = 284 * MiB  , W_DN_TMP = 198 * MiB  ;
constexpr size_t WS_WP = 742 * MiB;
constexpr size_t WS_HS = 1223 * MiB;
constexpr size_t WS_H = 743 * MiB;
constexpr size_t WS_PROJ = 807 * MiB;
constexpr size_t WS_Y = 967 * MiB;
constexpr size_t WS_ACT = WS_PROJ;
constexpr size_t WS_YN = 1031 * MiB;
constexpr size_t WS_MF = 1095 * MiB;
constexpr size_t WS_H8 = 1224 * MiB;
constexpr size_t WS_YS = WS_HS + 64 * 1024;
constexpr size_t WS_XS = 1428 * MiB;
constexpr size_t WS_END = 1492 * MiB;
constexpr size_t TMP_GU0 = 807 * MiB, TMP_IN0 = 979 * MiB, TMP_OUT0 = 1043 * MiB, TMP_IN1 = 1075 * MiB, TMP_OUT1 = 1139 * MiB, TMP_GU1 = 1256 * MiB;
static_assert(TMP_OUT1 + 32 * MiB <= WS_HS && TMP_GU1 + 172 * MiB <= WS_XS && WS_H8 + 32 * MiB <= TMP_GU1, "prologue temporaries");
static_assert((size_t)INW * DM * 2 == 80 * MiB && (size_t)DM * DM * 2 == 32 * MiB && (size_t)NGU * DM * 2 == 172 * MiB && (size_t)DM * DFF * 2 == 86 * MiB, "weight sizes");
static_assert((size_t)M * DFF * 2 <= WS_YN - WS_PROJ && (size_t)M * INW * 2 == 160 * MiB && (size_t)M * DM * 2 == 64 * MiB && (size_t)M * DM * 4 == 128 * MiB, "activation sizes");
constexpr int CW_TMO = 0, CW_BAR = 4096;

constexpr int RING_OFF = 0, RING_BYTES = 131072;
constexpr int LDSCTL_OFF = RING_BYTES, MISC_OFF = LDSCTL_OFF + 320;
constexpr int LDS_BYTES = 147456;
static_assert(MISC_OFF + 128 <= LDS_BYTES, "LDS map");

#define GAS __attribute__((address_space(1)))
#define LAS __attribute__((address_space(3)))
typedef unsigned short bf16;
typedef unsigned v4u __attribute__((ext_vector_type(4)));
typedef unsigned v2u __attribute__((ext_vector_type(2)));
typedef float f32x4 __attribute__((ext_vector_type(4)));
typedef float f32x16 __attribute__((ext_vector_type(16)));
typedef short bf16x8 __attribute__((ext_vector_type(8)));
typedef short s16x4 __attribute__((ext_vector_type(4)));
typedef GAS unsigned gu32;
#define RLX_AGENT __ATOMIC_RELAXED, __HIP_MEMORY_SCOPE_AGENT
#define LDS_WAIT() asm volatile("s_waitcnt lgkmcnt(0)" ::: "memory")
#define VM_WAIT() asm volatile("s_waitcnt vmcnt(0)" ::: "memory")
__device__ __forceinline__ unsigned f2bf(float f) { unsigned u = __builtin_bit_cast(unsigned, f); return (u + 0x7fffu + ((u >> 16) & 1u)) >> 16; }
__device__ __forceinline__ unsigned pk2(float lo, float hi) { return f2bf(lo) | (f2bf(hi) << 16); }
__device__ __forceinline__ float bflo(unsigned w) { return __builtin_bit_cast(float, w << 16); }
__device__ __forceinline__ float bfhi(unsigned w) { return __builtin_bit_cast(float, w & 0xffff0000u); }

#define XB_TMO      128
#define XB_XCNT(j)  (256  + 64 * (j))
#define XB_XSUB(j)  (1280 + 64 * (j))
#define XB_XGEN(j)  (2304 + 64 * (j))
#define XB_TOP      3328
#define XB_TOPGEN   3392
#define XCD_BAR_WORDS 3456
#define XB_SPIN_CAP (1u << 18)

__device__ __forceinline__ unsigned xb_ld(unsigned* p)              { return __hip_atomic_load(p, __ATOMIC_RELAXED, __HIP_MEMORY_SCOPE_AGENT); }
__device__ __forceinline__ unsigned xb_add(unsigned* p, unsigned v) { return __hip_atomic_fetch_add(p, v, __ATOMIC_RELAXED, __HIP_MEMORY_SCOPE_AGENT); }
__device__ __forceinline__ unsigned xb_xcc_id() { return (unsigned)__builtin_amdgcn_s_getreg((3 << 11) | 20) & 0xFu; }
#define XB_SPIN(cond, bar) do { unsigned _sp = 0; while (cond) { __builtin_amdgcn_s_sleep(1); \
    if ((++_sp & 255u) == 0u) { if (xb_ld(&(bar)[XB_TMO])) break; if (_sp > XB_SPIN_CAP) { atomicAdd(&(bar)[XB_TMO], 1u); break; } } } } while (0)

struct XcdBarrier {
    unsigned* bar; unsigned x;
    volatile LAS unsigned* st;
};

__device__ __forceinline__ XcdBarrier xcd_barrier_post(unsigned* bar, volatile LAS unsigned* st) {
    XcdBarrier b; b.bar = bar; b.x = xb_xcc_id(); b.st = st;
    if (threadIdx.x == 0) (void)xb_add(&bar[XB_XCNT(b.x)], 1u);
    return b;
}
__device__ __forceinline__ void xcd_barrier_complete(unsigned* bar, unsigned x, unsigned& nloc, unsigned& nx) {
    const unsigned G = gridDim.x * gridDim.y * gridDim.z;
    unsigned sum, cnt, mine, sp = 0u;
    for (;;) {
        sum = 0u; cnt = 0u; mine = 0u;
#pragma unroll
        for (unsigned j = 0; j < 16; ++j) { const unsigned c = xb_ld(&bar[XB_XCNT(j)]); sum += c; cnt += (c > 0u) ? 1u : 0u; mine = (j == x) ? c : mine; }
        if (sum == G) break;
        __builtin_amdgcn_s_sleep(1);
        if ((++sp & 255u) == 0u) { if (xb_ld(&bar[XB_TMO])) break; if (sp > XB_SPIN_CAP) { atomicAdd(&bar[XB_TMO], 1u); break; } }
    }
    nloc = mine > 0u ? mine : 1u; nx = cnt > 0u ? cnt : 1u;
}

__device__ __forceinline__ void xcd_barrier(const XcdBarrier& b) {
    asm volatile("s_waitcnt vmcnt(0)" ::: "memory");
    __syncthreads();
    if (threadIdx.x == 0) {
        unsigned* bar = b.bar;
        __builtin_amdgcn_s_waitcnt(0);
        unsigned nloc = b.st[0], nx = b.st[1];
        if (nloc == 0u) { xcd_barrier_complete(bar, b.x, nloc, nx); b.st[0] = nloc; b.st[1] = nx; }
        const unsigned old = xb_add(&bar[XB_XSUB(b.x)], 1u);
        const unsigned gen = old / nloc;
        if (old + 1u == (gen + 1u) * nloc) {
            __builtin_amdgcn_fence(__ATOMIC_RELEASE, "agent");
            asm volatile("s_waitcnt vmcnt(0)" ::: "memory");
            const unsigned og = xb_add(&bar[XB_TOP], 1u);
            const unsigned tg = og / nx;
            if (og + 1u == (tg + 1u) * nx) xb_add(&bar[XB_TOPGEN], 1u);
            else XB_SPIN(xb_ld(&bar[XB_TOPGEN]) == tg, bar);
            __builtin_amdgcn_fence(__ATOMIC_ACQUIRE, "agent");
            xb_add(&bar[XB_XGEN(b.x)], 1u);
            asm volatile("s_waitcnt vmcnt(0)" ::: "memory");
        } else {
            XB_SPIN(xb_ld(&bar[XB_XGEN(b.x)]) == gen, bar);
            __builtin_amdgcn_fence(__ATOMIC_ACQUIRE, "agent");
            asm volatile("s_waitcnt vmcnt(0)" ::: "memory");
        }
    }
    __syncthreads();
}

__device__ __forceinline__ float wave_sum(float v) {
#pragma unroll
    for (int o = 1; o < 64; o <<= 1) v += __shfl_xor(v, o);
    return v;
}
__device__ __forceinline__ float wave_max(float v) {
#pragma unroll
    for (int o = 1; o < 64; o <<= 1) v = fmaxf(v, __shfl_xor(v, o));
    return v;
}
__device__ __forceinline__ unsigned q8(float v, float inv) { return (unsigned)(int)__builtin_rintf(v * inv) & 0xffu; }
__device__ __forceinline__ void p0_transpose_item(const float* W, int K, int N, int ncols, bf16* WT, int blk, int stride, int off, LAS float* scr, int item, int lane, unsigned* cmax = nullptr) {
    const int nblk = ncols / 32, kb = item / nblk, nb = item % nblk, k0 = 64 * kb, n0 = 32 * nb;
    const int r0 = (n0 / blk) * stride + off + n0 % blk;
#pragma unroll 8
    for (int i = 0; i < 32; ++i) { const int kk = 2 * i + (lane >> 5); scr[kk * 33 + (lane & 31)] = W[(size_t)(k0 + kk) * N + n0 + (lane & 31)]; }
    LDS_WAIT(); asm volatile("" ::: "memory");
    const int c = lane & 7;
#pragma unroll
    for (int j = 0; j < 4; ++j) { const int n = (lane >> 3) + 8 * j; const LAS float* s = scr + (8 * c) * 33 + n;
        const float e0 = s[0 * 33], e1 = s[1 * 33], e2 = s[2 * 33], e3 = s[3 * 33], e4 = s[4 * 33], e5 = s[5 * 33], e6 = s[6 * 33], e7 = s[7 * 33];
        v4u o; o.x = pk2(e0, e1); o.y = pk2(e2, e3); o.z = pk2(e4, e5); o.w = pk2(e6, e7);
        *(GAS v4u*)(WT + (size_t)(r0 + n) * K + k0 + 8 * c) = o;
        if (cmax) {
            float mx = fmaxf(fmaxf(fmaxf(fabsf(e0), fabsf(e1)), fmaxf(fabsf(e2), fabsf(e3))), fmaxf(fmaxf(fabsf(e4), fabsf(e5)), fmaxf(fabsf(e6), fabsf(e7))));
            mx = fmaxf(mx, __shfl_xor(mx, 1)); mx = fmaxf(mx, __shfl_xor(mx, 2)); mx = fmaxf(mx, __shfl_xor(mx, 4));
            if (c == 0) (void)__hip_atomic_fetch_max(cmax + r0 + n, __builtin_bit_cast(unsigned, mx), __ATOMIC_RELAXED, __HIP_MEMORY_SCOPE_AGENT); } }
    LDS_WAIT(); asm volatile("" ::: "memory");
}

struct TDesc { const float* src; unsigned char* dst; const unsigned* cm; int N, pitch, mode; };
typedef float f32x2_t __attribute__((ext_vector_type(2)));
__device__ __forceinline__ void p0_tile_load(const TDesc& t, f32x2_t (&v)[32], int lane) {
    const GAS f32x2_t* p = (const GAS f32x2_t*)(t.src + (size_t)(lane >> 5) * t.N + 2 * (lane & 31)); const size_t st = (size_t)t.N;
#pragma unroll
    for (int i = 0; i < 32; ++i) v[i] = __builtin_nontemporal_load(p + (size_t)i * st);
}
__device__ __forceinline__ void p0_scale_load(const TDesc& t, float (&inv)[8], int lane) {
    if (t.mode != 0) { const float qm = t.mode == 1 ? 127.0f : 448.0f;
#pragma unroll
        for (int j = 0; j < 4; ++j) { const v2u c2 = *(const GAS v2u*)(t.cm + 2 * ((lane >> 3) + 8 * j)); const unsigned u0 = c2.x, u1 = c2.y; const float c0 = __builtin_bit_cast(float, u0), c1 = __builtin_bit_cast(float, u1);
            inv[j] = c0 > 0.f ? qm / c0 : 0.f; inv[4 + j] = c1 > 0.f ? qm / c1 : 0.f; } }
}
__device__ __forceinline__ unsigned q8s(float v, float inv) { return (unsigned)(int)__builtin_rintf(__builtin_amdgcn_fmed3f(v * inv, -127.0f, 127.0f)) & 0xffu; }
__device__ __forceinline__ float f8s(float v, float inv) { return __builtin_amdgcn_fmed3f(v * inv, -448.0f, 448.0f); }
__device__ __forceinline__ void p0_tile_store(const TDesc& t, const f32x2_t (&v)[32], LAS float* scr, int lane, const float (&inv)[8]) {
#pragma unroll
    for (int par = 0; par < 2; ++par) {
#pragma unroll
        for (int i = 0; i < 32; ++i) scr[(2 * i + (lane >> 5)) * 33 + (lane & 31)] = par == 0 ? v[i].x : v[i].y;
        LDS_WAIT(); asm volatile("" ::: "memory");
        const int c = lane & 7;
#pragma unroll
        for (int j = 0; j < 4; ++j) { const int n = (lane >> 3) + 8 * j; const LAS float* s = scr + (8 * c) * 33 + n; unsigned char* drow = t.dst + (size_t)(2 * n + par) * t.pitch;
            const float e0 = s[0 * 33], e1 = s[1 * 33], e2 = s[2 * 33], e3 = s[3 * 33], e4 = s[4 * 33], e5 = s[5 * 33], e6 = s[6 * 33], e7 = s[7 * 33];
            if (t.mode == 0) { v4u o; o.x = pk2(e0, e1); o.y = pk2(e2, e3); o.z = pk2(e4, e5); o.w = pk2(e6, e7);
                *(GAS v4u*)(drow + 16 * c) = o; }
            else if (t.mode == 1) { const float iv = inv[par * 4 + j]; v2u o;
                o.x = q8s(e0, iv) | (q8s(e1, iv) << 8) | (q8s(e2, iv) << 16) | (q8s(e3, iv) << 24); o.y = q8s(e4, iv) | (q8s(e5, iv) << 8) | (q8s(e6, iv) << 16) | (q8s(e7, iv) << 24);
                *(GAS v2u*)(drow + 8 * c) = o; }
            else { const float iv = inv[par * 4 + j]; int w0 = 0, w1 = 0;
                w0 = __builtin_amdgcn_cvt_pk_fp8_f32(f8s(e0, iv), f8s(e1, iv), w0, false); w0 = __builtin_amdgcn_cvt_pk_fp8_f32(f8s(e2, iv), f8s(e3, iv), w0, true);
                w1 = __builtin_amdgcn_cvt_pk_fp8_f32(f8s(e4, iv), f8s(e5, iv), w1, false); w1 = __builtin_amdgcn_cvt_pk_fp8_f32(f8s(e6, iv), f8s(e7, iv), w1, true);
                v2u o; o.x = (unsigned)w0; o.y = (unsigned)w1; *(GAS v2u*)(drow + 8 * c) = o; } }
        LDS_WAIT(); asm volatile("" ::: "memory"); }
}
__device__ __forceinline__ TDesc p0_tile_desc(const float* W, int K, int N, int ncols, unsigned char* WT, int mode, int blk, int stride, int off, int item, int KC, int kt, const unsigned* cmax) {
    const int nblk = ncols / 64, kc = item / nblk, nb = item - kc * nblk, k0 = 64 * (kc * KC + kt), n0 = 64 * nb, r0 = (n0 / blk) * stride + off + n0 % blk;
    const int es = mode == 0 ? 2 : 1;
    TDesc t; t.src = W + (size_t)k0 * N + n0; t.dst = WT + ((size_t)r0 * K + k0) * es; t.cm = cmax ? cmax + r0 : nullptr; t.N = N; t.pitch = K * es; t.mode = mode; return t;
}
constexpr float SAMPLE_MARGIN = 1.4f;
__device__ __forceinline__ void p0_sample_item(const float* W, int K, int N, int n, int q, unsigned* cm, int blk, int stride, int off) {
    const int rs = K / 256;
    const GAS f32x4* p = (const GAS f32x4*)(W + (size_t)(q * 64 * rs + rs / 2) * N + n); const size_t st = (size_t)rs * N / 4;
    f32x4 m = {0.f, 0.f, 0.f, 0.f};
#pragma unroll 1
    for (int s0 = 0; s0 < 64; s0 += 16) { f32x4 v[16];
#pragma unroll
        for (int s = 0; s < 16; ++s) v[s] = p[(size_t)(s0 + s) * st];
#pragma unroll
        for (int s = 0; s < 16; ++s) { m.x = fmaxf(m.x, fabsf(v[s].x)); m.y = fmaxf(m.y, fabsf(v[s].y)); m.z = fmaxf(m.z, fabsf(v[s].z)); m.w = fmaxf(m.w, fabsf(v[s].w)); } }
    unsigned* c = cm + (n / blk) * stride + off + n % blk;
    (void)__hip_atomic_fetch_max(c + 0, __builtin_bit_cast(unsigned, m.x * SAMPLE_MARGIN), __ATOMIC_RELAXED, __HIP_MEMORY_SCOPE_AGENT);
    (void)__hip_atomic_fetch_max(c + 1, __builtin_bit_cast(unsigned, m.y * SAMPLE_MARGIN), __ATOMIC_RELAXED, __HIP_MEMORY_SCOPE_AGENT);
    (void)__hip_atomic_fetch_max(c + 2, __builtin_bit_cast(unsigned, m.z * SAMPLE_MARGIN), __ATOMIC_RELAXED, __HIP_MEMORY_SCOPE_AGENT);
    (void)__hip_atomic_fetch_max(c + 3, __builtin_bit_cast(unsigned, m.w * SAMPLE_MARGIN), __ATOMIC_RELAXED, __HIP_MEMORY_SCOPE_AGENT);
}
__device__ __forceinline__ void p0_requant_load(const bf16* src, v4u (&v)[8], int lane) {
    const GAS v4u* sr = (const GAS v4u*)src + lane;
#pragma unroll
    for (int j = 0; j < 8; ++j) v[j] = __builtin_nontemporal_load(sr + 64 * j);
}
__device__ __forceinline__ void p0_requant_store(const v4u (&v)[8], unsigned cmbits, unsigned char* dst, int lane) {
    GAS v2u* dr = (GAS v2u*)dst + lane;
    const float cm = __builtin_bit_cast(float, cmbits); const float inv = cm > 0.f ? 127.0f / cm : 0.f;
#pragma unroll
    for (int j = 0; j < 8; ++j) { const v4u w = v[j]; v2u o;
        o.x = q8(bflo(w.x), inv) | (q8(bfhi(w.x), inv) << 8) | (q8(bflo(w.y), inv) << 16) | (q8(bfhi(w.y), inv) << 24);
        o.y = q8(bflo(w.z), inv) | (q8(bfhi(w.z), inv) << 8) | (q8(bflo(w.w), inv) << 16) | (q8(bfhi(w.w), inv) << 24);
        dr[64 * j] = o; }
}
__device__ __forceinline__ void p0_requant_row_f8(const bf16* src, unsigned cmbits, unsigned char* dst, int K, int lane) {
    const GAS v4u* sr = (const GAS v4u*)src; GAS v2u* dr = (GAS v2u*)dst;
    const float cm = __builtin_bit_cast(float, cmbits); const float inv = cm > 0.f ? 448.0f / cm : 0.f;
    for (int i = lane; i < K / 8; i += 64) { const v4u w = __builtin_nontemporal_load(sr + i); int w0 = 0, w1 = 0;
        w0 = __builtin_amdgcn_cvt_pk_fp8_f32(bflo(w.x) * inv, bfhi(w.x) * inv, w0, false); w0 = __builtin_amdgcn_cvt_pk_fp8_f32(bflo(w.y) * inv, bfhi(w.y) * inv, w0, true);
        w1 = __builtin_amdgcn_cvt_pk_fp8_f32(bflo(w.z) * inv, bfhi(w.z) * inv, w1, false); w1 = __builtin_amdgcn_cvt_pk_fp8_f32(bflo(w.w) * inv, bfhi(w.w) * inv, w1, true);
        v2u o; o.x = (unsigned)w0; o.y = (unsigned)w1; dr[i] = o; }
}
__device__ __forceinline__ void rms_row_to_bf16(const float* xrow, const LAS float* gain, bf16* hrow, unsigned char* h8row, float* hs, int lane) {
    const GAS f32x4* xr = (const GAS f32x4*)xrow + lane; const LAS f32x4* gr = (const LAS f32x4*)gain + lane;
    f32x4 v[16]; float s = 0.f;
#pragma unroll
    for (int j = 0; j < 16; ++j) { v[j] = xr[64 * j]; s += (v[j].x * v[j].x + v[j].y * v[j].y) + (v[j].z * v[j].z + v[j].w * v[j].w); }
    const float rstd = 1.0f / sqrtf(wave_sum(s) * (1.f / DM) + RMS_EPS);
    GAS v2u* o8 = (GAS v2u*)hrow + lane; float am = 0.f;
#pragma unroll
    for (int j = 0; j < 16; ++j) { const f32x4 g = gr[64 * j]; v[j] = v[j] * rstd * g; v2u w; w.x = pk2(v[j].x, v[j].y); w.y = pk2(v[j].z, v[j].w); o8[64 * j] = w;
        am = fmaxf(am, fmaxf(fmaxf(fabsf(v[j].x), fabsf(v[j].y)), fmaxf(fabsf(v[j].z), fabsf(v[j].w)))); }
    am = wave_max(am); const float inv = am > 0.f ? 127.0f / am : 0.f;
    GAS unsigned* o4 = (GAS unsigned*)h8row + lane;
#pragma unroll
    for (int j = 0; j < 16; ++j) o4[64 * j] = q8(v[j].x, inv) | (q8(v[j].y, inv) << 8) | (q8(v[j].z, inv) << 16) | (q8(v[j].w, inv) << 24);
    if (lane == 0) *hs = am * (1.0f / (127.0f * 127.0f));
}
template <bool XI32, bool XO32, bool HN>
__device__ __forceinline__ void resid_row(const bf16* mrow, const void* xin, const LAS float* gl, void* xout, bf16* hrow, unsigned char* h8row, float* hs, int lane) {
    const GAS v2u* mr = (const GAS v2u*)mrow + lane; const LAS f32x4* g1r = (const LAS f32x4*)gl + lane; const LAS f32x4* g2r = (const LAS f32x4*)(gl + DM) + lane;
    v2u mraw[16]; v2u xb[XI32 ? 1 : 16];
#pragma unroll
    for (int j = 0; j < 16; ++j) mraw[j] = mr[64 * j];
    if (!XI32) {
#pragma unroll
        for (int j = 0; j < 16; ++j) xb[j] = ((const GAS v2u*)xin + lane)[64 * j]; }
    f32x4 v[16]; float s = 0.f;
#pragma unroll
    for (int j = 0; j < 16; ++j) { v[j] = (f32x4){bflo(mraw[j].x), bfhi(mraw[j].x), bflo(mraw[j].y), bfhi(mraw[j].y)}; s += (v[j].x * v[j].x + v[j].y * v[j].y) + (v[j].z * v[j].z + v[j].w * v[j].w); }
    const float r1 = 1.0f / sqrtf(wave_sum(s) * (1.f / DM) + RMS_EPS);
    asm volatile("" ::: "memory");
    float s2 = 0.f;
#pragma unroll
    for (int j = 0; j < 16; ++j) { const f32x4 g = g1r[64 * j]; f32x4 x;
        if (XI32) x = ((const GAS f32x4*)xin + lane)[64 * j]; else x = (f32x4){bflo(xb[j].x), bfhi(xb[j].x), bflo(xb[j].y), bfhi(xb[j].y)};
        v[j] = x + v[j] * r1 * g;
        if (XO32) ((GAS f32x4*)xout + lane)[64 * j] = v[j]; else { v2u w; w.x = pk2(v[j].x, v[j].y); w.y = pk2(v[j].z, v[j].w); ((GAS v2u*)xout + lane)[64 * j] = w; }
        s2 += (v[j].x * v[j].x + v[j].y * v[j].y) + (v[j].z * v[j].z + v[j].w * v[j].w); }
    if (HN) {
        const float r2 = 1.0f / sqrtf(wave_sum(s2) * (1.f / DM) + RMS_EPS);
        asm volatile("" ::: "memory");
        GAS v2u* o8 = (GAS v2u*)hrow + lane; float am = 0.f;
#pragma unroll
        for (int j = 0; j < 16; ++j) { const f32x4 g = g2r[64 * j]; v[j] = v[j] * r2 * g; if (hrow) { v2u w; w.x = pk2(v[j].x, v[j].y); w.y = pk2(v[j].z, v[j].w); o8[64 * j] = w; }
            am = fmaxf(am, fmaxf(fmaxf(fabsf(v[j].x), fabsf(v[j].y)), fmaxf(fabsf(v[j].z), fabsf(v[j].w)))); }
        am = wave_max(am); const float inv = am > 0.f ? 127.0f / am : 0.f;
        GAS unsigned* o4 = (GAS unsigned*)h8row + lane;
#pragma unroll
        for (int j = 0; j < 16; ++j) o4[64 * j] = q8(v[j].x, inv) | (q8(v[j].y, inv) << 8) | (q8(v[j].z, inv) << 16) | (q8(v[j].w, inv) << 24);
        if (lane == 0) *hs = am * (1.0f / (127.0f * 127.0f));
    }
}
__device__ __forceinline__ void stage_gains(LAS float* gl, const float* g1, const float* g2, int tid) {
    for (int i = tid; i < DM / 4; i += NWAVES * 64) { ((LAS f32x4*)gl)[i] = ((const GAS f32x4*)g1)[i]; ((LAS f32x4*)(gl + DM))[i] = g2 ? ((const GAS f32x4*)g2)[i] : (f32x4){0.f, 0.f, 0.f, 0.f}; }
    LDS_WAIT(); __syncthreads();
}
__device__ __forceinline__ void mixnorm_row(const bf16* yrow, const LAS float* gain, unsigned char* yn8row, float* ys, int lane) {
    const GAS v4u* yr = (const GAS v4u*)yrow + lane;
    v4u v[8]; float f[8][8]; float am = 0.f;
#pragma unroll
    for (int j = 0; j < 8; ++j) v[j] = yr[64 * j];
#pragma unroll
    for (int g = 0; g < 4; ++g) { float s = 0.f;
#pragma unroll
        for (int jj = 0; jj < 2; ++jj) { const v4u w = v[2 * g + jj];
#pragma unroll
            for (int e = 0; e < 4; ++e) { const float a = bflo(w[e]), b = bfhi(w[e]); f[2 * g + jj][2 * e] = a; f[2 * g + jj][2 * e + 1] = b; s += a * a + b * b; } }
        const float rstd = 1.0f / sqrtf(wave_sum(s) * (1.f / GW) + RMS_EPS);
#pragma unroll
        for (int jj = 0; jj < 2; ++jj) { const int j = 2 * g + jj; const LAS f32x4* gp = (const LAS f32x4*)(gain + 512 * j + 8 * lane);
            const f32x4 ga = gp[0], gb = gp[1];
#pragma unroll
            for (int e = 0; e < 4; ++e) { f[j][e] *= rstd * ga[e]; f[j][4 + e] *= rstd * gb[e]; am = fmaxf(am, fmaxf(fabsf(f[j][e]), fabsf(f[j][4 + e]))); } }
    }
    am = wave_max(am); const float inv = am > 0.f ? 127.0f / am : 0.f;
    GAS v2u* yo = (GAS v2u*)yn8row + lane;
#pragma unroll
    for (int j = 0; j < 8; ++j) { v2u o; o.x = q8(f[j][0], inv) | (q8(f[j][1], inv) << 8) | (q8(f[j][2], inv) << 16) | (q8(f[j][3], inv) << 24);
        o.y = q8(f[j][4], inv) | (q8(f[j][5], inv) << 8) | (q8(f[j][6], inv) << 16) | (q8(f[j][7], inv) << 24); yo[64 * j] = o; }
    if (lane == 0) *ys = am * (1.0f / (127.0f * 127.0f));
}

namespace att {
constexpr int KVBLK = 64, SHM_K = 16384, SHM_V = 16384;
constexpr int OFF_V = 0, OFF_K = 2 * SHM_V, OFF_WS = OFF_K + 2 * SHM_K, OFF_KM = OFF_WS + NWAVES * 64 * 4, OFF_DONE = OFF_KM + 8 * 128 * 4, ATT_LDS = OFF_DONE + 64;
static_assert(ATT_LDS <= RING_BYTES, "attention LDS inside the ring region");
constexpr float C2 = 0.08838834764831845f * 1.4426950408889634f;
constexpr int LDP = INW;
#define KSWZ(row, colB) ((row) * 256 + ((colB) ^ (((row) & 15) << 4)))
#define SBAR() __builtin_amdgcn_sched_barrier(0)
__device__ __forceinline__ int v_st(int k, int c) { const int kk = (k & ~0xC) | ((k & 4) << 1) | ((k & 8) >> 1); return ((kk >> 3) * 4 + (c >> 5)) * 512 + ((kk & 7) * 32 + (c & 31)) * 2; }
__device__ __forceinline__ int v_rd_base(int lane) { return ((lane & 3) << 3) | (((lane >> 2) & 3) << 6) | (((lane >> 4) & 1) << 5) | (((lane >> 5) & 1) << 8); }
constexpr int v_rd_off(int d0, int ks, int half) { return d0 * 512 + ks * 4096 + half * 2048; }
__device__ __forceinline__ int crow(int r, int hi) { return (r & 3) + 8 * (r >> 2) + 4 * hi; }
typedef float f32x2_cv __attribute__((ext_vector_type(2))); typedef __bf16 bf16x2_cv __attribute__((ext_vector_type(2)));
__device__ __forceinline__ unsigned cvtpk(float lo, float hi) { const f32x2_cv v = {lo, hi}; return __builtin_bit_cast(unsigned, __builtin_convertvector(v, bf16x2_cv)); }
__device__ __forceinline__ float swap_max(float v) { auto rr = __builtin_amdgcn_permlane32_swap(__float_as_uint(v), __float_as_uint(v), false, false); return fmaxf(__uint_as_float(rr[0]), __uint_as_float(rr[1])); }
__device__ __forceinline__ float swap_sum(float v) { auto rr = __builtin_amdgcn_permlane32_swap(__float_as_uint(v), __float_as_uint(v), false, false); return __uint_as_float(rr[0]) + __uint_as_float(rr[1]); }

__device__ __forceinline__ void qkt(f32x16& p0, f32x16& p1, const LAS char* Kt, int r32, int hi, const bf16x8* qr) {
    p0 = f32x16{}; p1 = f32x16{};
    int ko[4];
#pragma unroll
    for (int dd = 0; dd < 4; ++dd) ko[dd] = KSWZ(r32, (dd * 16 + hi * 8) * 2);
    bf16x8 fa[8], fb[8];
#pragma unroll
    for (int i = 0; i < 4; ++i) { fa[2 * i] = *(const LAS bf16x8*)(Kt + ko[i]); fa[2 * i + 1] = *(const LAS bf16x8*)(Kt + ko[i] + 32 * 256); }
    asm volatile("" : "+v"(fa[0]), "+v"(fa[1]), "+v"(fa[2]), "+v"(fa[3]), "+v"(fa[4]), "+v"(fa[5]), "+v"(fa[6]), "+v"(fa[7]));
    __builtin_amdgcn_s_setprio(1);
#pragma unroll
    for (int i = 0; i < 4; ++i) { p0 = __builtin_amdgcn_mfma_f32_32x32x16_bf16(fa[2 * i], qr[i], p0, 0, 0, 0); p1 = __builtin_amdgcn_mfma_f32_32x32x16_bf16(fa[2 * i + 1], qr[i], p1, 0, 0, 0); }
    __builtin_amdgcn_s_setprio(0);
#pragma unroll
    for (int i = 0; i < 4; ++i) { fb[2 * i] = *(const LAS bf16x8*)(Kt + (ko[i] ^ 128)); fb[2 * i + 1] = *(const LAS bf16x8*)(Kt + (ko[i] ^ 128) + 32 * 256); }
    asm volatile("" : "+v"(fb[0]), "+v"(fb[1]), "+v"(fb[2]), "+v"(fb[3]), "+v"(fb[4]), "+v"(fb[5]), "+v"(fb[6]), "+v"(fb[7]));
    __builtin_amdgcn_s_setprio(1);
#pragma unroll
    for (int i = 0; i < 4; ++i) { p0 = __builtin_amdgcn_mfma_f32_32x32x16_bf16(fb[2 * i], qr[4 + i], p0, 0, 0, 0); p1 = __builtin_amdgcn_mfma_f32_32x32x16_bf16(fb[2 * i + 1], qr[4 + i], p1, 0, 0, 0); }
    __builtin_amdgcn_s_setprio(0);
}
__device__ __forceinline__ void pv_tile(f32x16* o, unsigned vb, bf16x8 pa0, bf16x8 pa1, bf16x8 pa2, bf16x8 pa3) {
#define TRRD(dst, off) asm volatile("ds_read_b64_tr_b16 %0, %1 offset:%2" : "=&v"(dst) : "v"(vb), "i"(off) : "memory")
#define PV_RD(S, d0) do { constexpr int b_ = v_rd_off(d0, 0, 0); TRRD(S##l0, b_); TRRD(S##h0, b_ + 2048); TRRD(S##l1, b_ + 4096); TRRD(S##h1, b_ + 6144); TRRD(S##l2, b_ + 8192); TRRD(S##h2, b_ + 10240); TRRD(S##l3, b_ + 12288); TRRD(S##h3, b_ + 14336); } while (0)
#define PV_MM(S, d0) do { __builtin_amdgcn_s_setprio(1); \
        o[d0] = __builtin_amdgcn_mfma_f32_32x32x16_bf16(pa0, (bf16x8){S##l0[0], S##l0[1], S##l0[2], S##l0[3], S##h0[0], S##h0[1], S##h0[2], S##h0[3]}, o[d0], 0, 0, 0); \
        o[d0] = __builtin_amdgcn_mfma_f32_32x32x16_bf16(pa1, (bf16x8){S##l1[0], S##l1[1], S##l1[2], S##l1[3], S##h1[0], S##h1[1], S##h1[2], S##h1[3]}, o[d0], 0, 0, 0); \
        o[d0] = __builtin_amdgcn_mfma_f32_32x32x16_bf16(pa2, (bf16x8){S##l2[0], S##l2[1], S##l2[2], S##l2[3], S##h2[0], S##h2[1], S##h2[2], S##h2[3]}, o[d0], 0, 0, 0); \
        o[d0] = __builtin_amdgcn_mfma_f32_32x32x16_bf16(pa3, (bf16x8){S##l3[0], S##l3[1], S##l3[2], S##l3[3], S##h3[0], S##h3[1], S##h3[2], S##h3[3]}, o[d0], 0, 0, 0); __builtin_amdgcn_s_setprio(0); } while (0)
    s16x4 Al0, Al1, Al2, Al3, Ah0, Ah1, Ah2, Ah3, Bl0, Bl1, Bl2, Bl3, Bh0, Bh1, Bh2, Bh3;
    PV_RD(A, 0);
    PV_RD(B, 1); asm volatile("s_waitcnt lgkmcnt(8)" ::: "memory"); SBAR(); PV_MM(A, 0); SBAR();
    PV_RD(A, 2); asm volatile("s_waitcnt lgkmcnt(8)" ::: "memory"); SBAR(); PV_MM(B, 1); SBAR();
    PV_RD(B, 3); asm volatile("s_waitcnt lgkmcnt(8)" ::: "memory"); SBAR(); PV_MM(A, 2); SBAR();
    asm volatile("s_waitcnt lgkmcnt(0)" ::: "memory"); SBAR(); PV_MM(B, 3);
#undef PV_MM
#undef PV_RD
#undef TRRD
}
__device__ __forceinline__ void pack_p(const f32x16& p0, const f32x16& p1, bf16x8& pa0, bf16x8& pa1, bf16x8& pa2, bf16x8& pa3) {
#define PK4(P, B_, OUT) do { unsigned a0 = cvtpk(P[B_+0], P[B_+1]), a1 = cvtpk(P[B_+2], P[B_+3]); \
        unsigned b0 = cvtpk(P[B_+4], P[B_+5]), b1 = cvtpk(P[B_+6], P[B_+7]); \
        auto r0 = __builtin_amdgcn_permlane32_swap(a0, b0, false, false); auto r1 = __builtin_amdgcn_permlane32_swap(a1, b1, false, false); \
        v4u w = {r0[0], r1[0], r0[1], r1[1]}; OUT = __builtin_bit_cast(bf16x8, w); } while (0)
    PK4(p0, 0, pa0); PK4(p0, 8, pa1); PK4(p1, 0, pa2); PK4(p1, 8, pa3);
#undef PK4
}

template <int MODE>
__device__ __forceinline__ void attn_block(const bf16* __restrict__ proj, bf16* __restrict__ y, const float* __restrict__ ksum, int b, int h, int qb, LAS char* lds) {
    int tid = threadIdx.x; asm volatile("" : "+v"(tid));
    const int wid = __builtin_amdgcn_readfirstlane(tid >> 6), lane = tid & 63, r32 = lane & 31, hi = lane >> 5;
    constexpr int QCOL = MODE == 0 ? 0 : (MODE == 1 ? 6144 : 3072), YCOL = MODE == 0 ? 0 : (MODE == 1 ? 3072 : 1024);
    const size_t rowbase = (size_t)b * SEQ; const int q0 = qb * 256;
    const bf16* Kg = proj + rowbase * LDP + QCOL + GW + h * HD; const bf16* Vg = Kg + GW;
    LAS char* V_lds = lds + OFF_V; LAS char* K_lds = lds + OFF_K;
    LAS float* ws = (LAS float*)(lds + OFF_WS) + wid * 64; LAS float* li_l = ws; LAS float* al_l = ws + 32;
    LAS float* km = (LAS float*)(lds + OFF_KM); LAS unsigned* donef = (LAS unsigned*)(lds + OFF_DONE);
    const int sr = tid >> 4, sc = (tid & 15) * 8, vst0 = v_st(sr, sc), vst1 = v_st(32 + sr, sc), kws = KSWZ(sr, sc * 2);
    const unsigned vb0 = (unsigned)(uintptr_t)V_lds + (unsigned)v_rd_base(lane);
    const int qpos = q0 + wid * 32 + r32;
    const int NT = 4 * (qb + 1);
    bf16x8 qr[8];
    { const bf16* Qp = proj + (rowbase + qpos) * LDP + QCOL + h * HD + hi * 8;
#pragma unroll
      for (int d0 = 0; d0 < 8; ++d0) qr[d0] = *(const GAS bf16x8*)(Qp + d0 * 16); }
    bf16x8 st_k0, st_k1, st_v0, st_v1;
#define TILE_OF(it) (MODE == 2 ? (NT - 1 - (it)) : (it))
#define SLOAD(kb) do { const bf16* kp_ = Kg + (size_t)((kb) + sr) * LDP + sc; const bf16* vp_ = Vg + (size_t)((kb) + sr) * LDP + sc; \
        st_k0 = *(const GAS bf16x8*)kp_; st_k1 = *(const GAS bf16x8*)(kp_ + 32 * LDP); st_v0 = *(const GAS bf16x8*)vp_; st_v1 = *(const GAS bf16x8*)(vp_ + 32 * LDP); } while (0)
#define SWRITE(bf) do { *(LAS bf16x8*)(K_lds + (bf) * SHM_K + kws) = st_k0; *(LAS bf16x8*)(K_lds + (bf) * SHM_K + kws + 32 * 256) = st_k1; \
        *(LAS bf16x8*)(V_lds + (bf) * SHM_V + vst0) = st_v0; *(LAS bf16x8*)(V_lds + (bf) * SHM_V + vst1) = st_v1; } while (0)
    SLOAD(TILE_OF(0) * KVBLK);
    unsigned selmask = 0u;
    if (MODE == 0) {
        if (qb > 0) { for (int i = tid; i < qb * 32; i += 512) { const int n = i >> 5, c4 = (i & 31) * 4;
            *(LAS f32x4*)(km + n * 128 + c4) = *(const GAS f32x4*)(ksum + (size_t)(b * 8 + n) * 1024 + h * HD + c4); } }
    }
    SWRITE(0);
    __syncthreads();
    if (MODE == 0 && qb > 0) {
        float g[7];
#pragma unroll
        for (int n = 0; n < 7; ++n) { float a = 0.f;
            if (n < qb) {
#pragma unroll
                for (int d0 = 0; d0 < 8; ++d0) { const f32x4 ka = *(const LAS f32x4*)(km + n * 128 + d0 * 16 + hi * 8), kb2 = *(const LAS f32x4*)(km + n * 128 + d0 * 16 + hi * 8 + 4);
                    const v4u qw = __builtin_bit_cast(v4u, qr[d0]);
                    a += bflo(qw.x) * ka.x + bfhi(qw.x) * ka.y + bflo(qw.y) * ka.z + bfhi(qw.y) * ka.w + bflo(qw.z) * kb2.x + bfhi(qw.z) * kb2.y + bflo(qw.w) * kb2.z + bfhi(qw.w) * kb2.w; }
                a = swap_sum(a); }
            g[n] = a; }
#pragma unroll
        for (int n = 0; n < 7; ++n) { int rank = 0;
#pragma unroll
            for (int m2 = 0; m2 < 7; ++m2) if (m2 != n) rank += (m2 < qb && (g[m2] > g[n] || (g[m2] == g[n] && m2 < n))) ? 1 : 0;
            if (n < qb && rank < 3) selmask |= 1u << n; }
    }
    unsigned m16mask = 0u, m4mask = 0u;
    if (MODE == 1) {
#pragma unroll
        for (int r = 0; r < 16; ++r) { const int c = (r & 3) + 8 * (r >> 2); if (((qpos - 4 * hi - c) & 15) == 0) m16mask |= 1u << r; }
#pragma unroll
        for (int r = 0; r < 4; ++r) if (((qpos - 4 * hi - r) & 3) == 0) m4mask |= 1u << r;
    }
    float m_run = -1e30f, l_run = 0.f, R2 = 0.f; f32x16 o[4] = {};
    const int qhi = q0 + wid * 32 + 31;
    bool wdone = false;
    for (int it = 0; it < NT; ++it) {
        const int j = TILE_OF(it), kbase = j * KVBLK, buf = it & 1;
        const bool more = it + 1 < NT;
        if (more) SLOAD(TILE_OF(it + 1) * KVBLK);
        bool act;
        if (MODE == 0) act = (j >> 2) == qb ? (kbase <= qhi) : (__any((selmask >> (j >> 2)) & 1u) != 0);
        else if (MODE == 1) act = kbase <= qhi;
        else act = (kbase < qhi) && !wdone;
        if (act) {
            f32x16 p0, p1;
            qkt(p0, p1, K_lds + buf * SHM_K, r32, hi, qr); SBAR();
            const int dq = qpos - kbase - 4 * hi;
            bf16x8 pa0, pa1, pa2, pa3;
            if (MODE == 2) {
                f32x16 z0, z1;
#pragma unroll
                for (int r = 0; r < 16; ++r) { z0[r] = p0[r] * C2; z1[r] = p1[r] * C2; }
#pragma unroll
                for (int r = 0; r < 16; ++r) { const int c = (r & 3) + 8 * (r >> 2);
                    const float t0 = __builtin_amdgcn_exp2f(-fabsf(z0[r])), t1 = __builtin_amdgcn_exp2f(-fabsf(z1[r]));
                    const float s0 = fmaxf(z0[r], 0.f) + __builtin_amdgcn_logf(1.0f + t0), s1 = fmaxf(z1[r], 0.f) + __builtin_amdgcn_logf(1.0f + t1);
                    p0[r] = (dq - c >= 1) ? -s0 : 0.f; p1[r] = (dq - c - 32 >= 1) ? -s1 : 0.f; }
                float G[8], T[8];
#pragma unroll
                for (int k = 0; k < 8; ++k) { G[k] = k < 4 ? (p0[4 * k] + p0[4 * k + 1]) + (p0[4 * k + 2] + p0[4 * k + 3]) : (p1[4 * k - 16] + p1[4 * k - 15]) + (p1[4 * k - 14] + p1[4 * k - 13]);
                    T[k] = swap_sum(G[k]); }
                float st = 0.f;
#pragma unroll
                for (int k = 7; k >= 0; --k) { const float eg = R2 + st + (hi == 0 ? T[k] - G[k] : 0.f);
                    st += T[k];
                    if (k < 4) { const float l3 = p0[4 * k + 3], l2 = p0[4 * k + 2], l1 = p0[4 * k + 1], l0 = p0[4 * k];
                        const float e3 = eg, e2 = eg + l3, e1 = e2 + l2, e0 = e1 + l1;
                        p0[4 * k + 3] = z0[4 * k + 3] + l3 + e3; p0[4 * k + 2] = z0[4 * k + 2] + l2 + e2; p0[4 * k + 1] = z0[4 * k + 1] + l1 + e1; p0[4 * k] = z0[4 * k] + l0 + e0; }
                    else { const int q4 = 4 * k - 16; const float l3 = p1[q4 + 3], l2 = p1[q4 + 2], l1 = p1[q4 + 1], l0 = p1[q4];
                        const float e3 = eg, e2 = eg + l3, e1 = e2 + l2, e0 = e1 + l1;
                        p1[q4 + 3] = z1[q4 + 3] + l3 + e3; p1[q4 + 2] = z1[q4 + 2] + l2 + e2; p1[q4 + 1] = z1[q4 + 1] + l1 + e1; p1[q4] = z1[q4] + l0 + e0; } }
                R2 += st;
#pragma unroll
                for (int r = 0; r < 16; ++r) { const int c = (r & 3) + 8 * (r >> 2);
                    p0[r] = (dq - c >= 1) ? __builtin_amdgcn_exp2f(p0[r]) : 0.f; p1[r] = (dq - c - 32 >= 1) ? __builtin_amdgcn_exp2f(p1[r]) : 0.f; }
                SBAR(); pack_p(p0, p1, pa0, pa1, pa2, pa3); SBAR();
                pv_tile(o, vb0 + buf * SHM_V, pa0, pa1, pa2, pa3);
                wdone = __all(R2 < -150.f) != 0;
            } else {
                const float NEG = -__builtin_inff();
                constexpr float THR2 = 11.5f;
                float nb;
                float pmax;
                if (MODE == 0) {
                    const bool own = (j >> 2) == qb;
                    if (own) {
#pragma unroll
                        for (int r = 0; r < 16; ++r) { const int c = (r & 3) + 8 * (r >> 2); p0[r] = (dq - c >= 0) ? p0[r] : NEG; p1[r] = (dq - c - 32 >= 0) ? p1[r] : NEG; } }
                    pmax = p0[0];
#pragma unroll
                    for (int r = 1; r < 16; ++r) pmax = fmaxf(pmax, p0[r]);
#pragma unroll
                    for (int r = 0; r < 16; ++r) pmax = fmaxf(pmax, p1[r]);
                    const bool sel = own || (((selmask >> (j >> 2)) & 1u) != 0u);
                    pmax = swap_max(sel ? pmax * C2 : NEG);
                    float mn = m_run, alpha = 1.0f;
                    if (!__all(pmax - m_run <= THR2)) { mn = fmaxf(m_run, pmax); alpha = __builtin_amdgcn_exp2f(m_run - mn); m_run = mn;
                        if (hi == 0) al_l[r32] = alpha; LDS_WAIT();
#pragma unroll
                        for (int r = 0; r < 16; ++r) { const float a = al_l[crow(r, hi)];
#pragma unroll
                            for (int d_ = 0; d_ < 4; ++d_) o[d_][r] *= a; }
                        LDS_WAIT(); }
                    nb = sel ? -mn : NEG; float ps = 0.f;
#pragma unroll
                    for (int r = 0; r < 16; ++r) { p0[r] = __builtin_amdgcn_exp2f(fmaf(p0[r], C2, nb)); p1[r] = __builtin_amdgcn_exp2f(fmaf(p1[r], C2, nb)); ps += p0[r] + p1[r]; }
                    ps = swap_sum(ps);
                    l_run = l_run * alpha + ps;
                } else {
                    const int qlo = qhi - 31;
                    unsigned m16_l = m16mask, m4_l = m4mask; asm volatile("" : "+v"(m16_l), "+v"(m4_l));
                    if (kbase + 63 < qlo - 512) {
#pragma unroll
                        for (int r = 0; r < 16; ++r) { const float bf_ = ((m16_l >> r) & 1u) ? 0.0f : NEG; p0[r] = fmaf(p0[r], C2, bf_); p1[r] = fmaf(p1[r], C2, bf_); }
                    } else if (kbase + 63 < qlo - 128 && kbase >= qhi - 512) {
#pragma unroll
                        for (int r = 0; r < 16; ++r) { const float bm_ = ((m4_l >> (r & 3)) & 1u) ? (((m16_l >> r) & 1u) ? 1.0f : 0.0f) : NEG; p0[r] = fmaf(p0[r], C2, bm_); p1[r] = fmaf(p1[r], C2, bm_); }
                    } else {
#pragma unroll
                        for (int r = 0; r < 16; ++r) { const int c = (r & 3) + 8 * (r >> 2); const int m4_ = (int)((m4_l >> (r & 3)) & 1u), m16_ = (int)((m16_l >> r) & 1u);
                            const int d0_ = dq - c, d1_ = d0_ - 32;
                            const int c0_ = ((unsigned)d0_ <= 128u ? 1 : 0) + (((unsigned)d0_ <= 512u ? 1 : 0) & m4_) + ((d0_ >= 0 ? 1 : 0) & m16_);
                            const int c1_ = ((unsigned)d1_ <= 128u ? 1 : 0) + (((unsigned)d1_ <= 512u ? 1 : 0) & m4_) + ((d1_ >= 0 ? 1 : 0) & m16_);
                            const float l0_ = c0_ == 0 ? NEG : (c0_ == 3 ? 1.5849625007211562f : (float)(c0_ - 1)), l1_ = c1_ == 0 ? NEG : (c1_ == 3 ? 1.5849625007211562f : (float)(c1_ - 1));
                            p0[r] = fmaf(p0[r], C2, l0_); p1[r] = fmaf(p1[r], C2, l1_); }
                    }
                    pmax = p0[0];
#pragma unroll
                    for (int r = 1; r < 16; ++r) pmax = fmaxf(pmax, p0[r]);
#pragma unroll
                    for (int r = 0; r < 16; ++r) pmax = fmaxf(pmax, p1[r]);
                    pmax = swap_max(pmax);
                    float mn = m_run, alpha = 1.0f;
                    if (!__all(pmax - m_run <= THR2)) { mn = fmaxf(m_run, pmax); alpha = __builtin_amdgcn_exp2f(m_run - mn); m_run = mn;
                        if (hi == 0) al_l[r32] = alpha; LDS_WAIT();
#pragma unroll
                        for (int r = 0; r < 16; ++r) { const float a = al_l[crow(r, hi)];
#pragma unroll
                            for (int d_ = 0; d_ < 4; ++d_) o[d_][r] *= a; }
                        LDS_WAIT(); }
                    float ps = 0.f;
#pragma unroll
                    for (int r = 0; r < 16; ++r) { p0[r] = __builtin_amdgcn_exp2f(p0[r] - mn); p1[r] = __builtin_amdgcn_exp2f(p1[r] - mn); ps += p0[r] + p1[r]; }
                    ps = swap_sum(ps);
                    l_run = l_run * alpha + ps;
                }
                SBAR(); pack_p(p0, p1, pa0, pa1, pa2, pa3); SBAR();
                pv_tile(o, vb0 + buf * SHM_V, pa0, pa1, pa2, pa3);
            }
        }
        if (more) SWRITE(buf ^ 1);
        if (MODE == 2) { if (lane == 0) donef[(it & 1) * 8 + wid] = wdone ? 1u : 0u; }
        __syncthreads();
        if (MODE == 2) { unsigned alld = 1u;
#pragma unroll
            for (int w8 = 0; w8 < 8; ++w8) alld &= donef[(it & 1) * 8 + w8];
            if (alld) break; }
    }
    if (MODE != 2) { if (hi == 0) li_l[r32] = l_run; LDS_WAIT(); }
    int tz = tid; asm volatile("" : "+v"(tz));
    const int er32 = tz & 31, ehi = (tz >> 5) & 1;
    bf16* Ow = y + (rowbase + q0 + wid * 32 + 4 * ehi) * DM + YCOL + h * HD + er32;
#pragma unroll
    for (int r = 0; r < 16; ++r) { const int orow = (r & 3) + 8 * (r >> 2); const float rl = MODE != 2 ? __builtin_amdgcn_rcpf(li_l[orow + 4 * ehi]) : 1.0f;
#pragma unroll
        for (int d0 = 0; d0 < 4; ++d0) { const float v = o[d0][r] * rl; const float vn = __shfl_xor(v, 1);
            if ((er32 & 1) == 0) *(GAS unsigned*)(Ow + (size_t)orow * DM + d0 * 32) = cvtpk(v, vn); } }
    LDS_WAIT();
    __syncthreads();
#undef TILE_OF
#undef SLOAD
#undef SWRITE
}

typedef float f32x4_t __attribute__((ext_vector_type(4)));
constexpr int POOL_PITCH = 528, POOL_ROWS = 128 + 15;
static_assert(POOL_ROWS * POOL_PITCH <= RING_BYTES && 256 * 512 <= RING_BYTES, "pool tile / staged wpool^T inside the ring region");
template <int W>
__device__ __forceinline__ void pool_item_w(const bf16* __restrict__ proj, const bf16* __restrict__ wpt, const float* __restrict__ pscale, bf16* __restrict__ y, int g, int tt, LAS char* lds) {
    int tid = threadIdx.x; asm volatile("" : "+v"(tid));
    const int wid = __builtin_amdgcn_readfirstlane(tid >> 6), lane = tid & 63, c16 = lane & 15, kq = lane >> 4;
    const int t0 = tt * 128, s0 = t0 & (SEQ - 1);
    { const bf16* ug = proj + (size_t)(t0 - 15) * LDP + 9 * GW + g * 256;
#pragma unroll
      for (int j = 0; j < 9; ++j) { const int i = tid + 512 * j; if (i < POOL_ROWS * 32) { const int rr = i >> 5, ch = i & 31;
          v4u v = (v4u){0u, 0u, 0u, 0u}; if (s0 - 15 + rr >= 0) v = *(const GAS v4u*)(ug + (size_t)rr * LDP + ch * 8);
          *(LAS v4u*)(lds + rr * POOL_PITCH + ch * 16) = v; } } }
    __syncthreads();
    v4u astg[16];
    { const bf16* wa = wpt + (size_t)g * 256 * 256;
#pragma unroll
      for (int j = 0; j < 16; ++j) { const int i = tid + 512 * j; astg[j] = *(const GAS v4u*)(wa + (size_t)(i >> 5) * 256 + (i & 31) * 8); } }
    SBAR();
    const int tl = wid * 16 + c16, t = t0 + tl, s = s0 + tl;
    const int cnt = (s + 1 < W) ? s + 1 : W; const float inv = 1.0f / (float)cnt;
    const LAS char* ul = lds + (15 + tl) * POOL_PITCH + kq * 16;
    bf16x8 bfr[8];
#pragma unroll
    for (int ks = 0; ks < 8; ++ks) {
        float sm[8] = {0.f, 0.f, 0.f, 0.f, 0.f, 0.f, 0.f, 0.f}; float u0[8];
#pragma unroll
        for (int jj = 0; jj < W; ++jj) { const v4u q = *(const LAS v4u*)(ul - jj * POOL_PITCH + ks * 64);
            const float e[8] = {bflo(q.x), bfhi(q.x), bflo(q.y), bfhi(q.y), bflo(q.z), bfhi(q.z), bflo(q.w), bfhi(q.w)};
#pragma unroll
            for (int i = 0; i < 8; ++i) { sm[i] += e[i]; if (jj == 0) u0[i] = e[i]; } }
        v4u bw; bw.x = cvtpk(sm[0] * inv - u0[0], sm[1] * inv - u0[1]); bw.y = cvtpk(sm[2] * inv - u0[2], sm[3] * inv - u0[3]);
        bw.z = cvtpk(sm[4] * inv - u0[4], sm[5] * inv - u0[5]); bw.w = cvtpk(sm[6] * inv - u0[6], sm[7] * inv - u0[7]);
        bfr[ks] = __builtin_bit_cast(bf16x8, bw); }
    LDS_WAIT();
    __syncthreads();
#pragma unroll
    for (int j = 0; j < 16; ++j) { const int i = tid + 512 * j, row = i >> 5; *(LAS v4u*)(lds + row * 512 + (((i & 31) ^ (row & 15)) * 16)) = astg[j]; }
    LDS_WAIT();
    __syncthreads();
    const LAS char* al = lds + c16 * 512 + ((kq ^ (c16 & 3)) * 16); const int hx = (c16 & 12) * 16;
    f32x4_t acc[16];
#pragma unroll
    for (int db = 0; db < 16; ++db) { acc[db] = (f32x4_t){0.f, 0.f, 0.f, 0.f};
#pragma unroll
        for (int ks = 0; ks < 8; ++ks) { const bf16x8 afr = *(const LAS bf16x8*)(al + db * 16 * 512 + ((ks * 64) ^ hx)); acc[db] = __builtin_amdgcn_mfma_f32_16x16x32_bf16(afr, bfr[ks], acc[db], 0, 0, 0); } }
    bf16* yo = y + (size_t)t * DM + 2 * GW + g * 256 + 4 * kq;
    const float* psc = pscale + g * 256 + 4 * kq;
    f32x4 sc4[16];
#pragma unroll
    for (int db = 0; db < 16; ++db) sc4[db] = *(const GAS f32x4*)(psc + db * 16);
#pragma unroll
    for (int db = 0; db < 16; ++db) { v2u ww; ww.x = cvtpk(acc[db][0] * sc4[db].x, acc[db][1] * sc4[db].y); ww.y = cvtpk(acc[db][2] * sc4[db].z, acc[db][3] * sc4[db].w);
        *(GAS v2u*)(yo + db * 16) = ww; }
    __syncthreads();
}
__device__ __forceinline__ void pool_item(const bf16* __restrict__ proj, const bf16* __restrict__ wpt, const float* __restrict__ pscale, bf16* __restrict__ y, int g, int tt, LAS char* lds) {
    if (g == 0) pool_item_w<2>(proj, wpt, pscale, y, g, tt, lds); else if (g == 1) pool_item_w<4>(proj, wpt, pscale, y, g, tt, lds);
    else if (g == 2) pool_item_w<8>(proj, wpt, pscale, y, g, tt, lds); else pool_item_w<16>(proj, wpt, pscale, y, g, tt, lds);
}
}

#ifdef SKIP_ATT0
#define ATT0(...)
#else
#define ATT0(...) __VA_ARGS__
#endif
#ifdef SKIP_ATT1
#define ATT1(...)
#else
#define ATT1(...) __VA_ARGS__
#endif
#ifdef SKIP_ATT2
#define ATT2(...)
#else
#define ATT2(...) __VA_ARGS__
#endif
#ifdef SKIP_POOL
#define POOL(...)
#else
#define POOL(...) __VA_ARGS__
#endif
#ifdef SKIP_GEMM1
#define GEMM1(...)
#else
#define GEMM1(...) __VA_ARGS__
#endif
#ifdef SKIP_GEMM2
#define GEMM2(...)
#else
#define GEMM2(...) __VA_ARGS__
#endif
#ifdef SKIP_GEMM3
#define GEMM3(...)
#else
#define GEMM3(...) __VA_ARGS__
#endif

constexpr int NPHASE = 2 + 8 * DEPTH;
struct Args { const float* in[13]; float* out; unsigned char* ws; int ph_lo, ph_hi, sub, pad; };
static_assert(sizeof(Args) == 136, "Args has no padding bytes");

typedef const __attribute__((address_space(4))) Args* KArgs;
__device__ __forceinline__ KArgs kargs() { KArgs p = (KArgs)__builtin_amdgcn_kernarg_segment_ptr(); asm volatile("" : "+s"(p)); return p; }
__device__ __forceinline__ int vcu_of(int G) { const int bx = blockIdx.x; return (G % 8 == 0) ? (bx % 8) * (G / 8) + bx / 8 : bx; }
template <int SP>
__device__ __forceinline__ void p0_work(const KArgs A, unsigned char* const ws, LAS unsigned char* lds, int lane, int wave, int gw, int NGW, int tid_) {
    if (SP == 0) {
        constexpr int SG_IN = 8192 / 256, SG_OUT = DM / 256, SG_G = DFF / 256, SG_D = DM / 256, SG_LAYER = SG_IN + SG_OUT + 2 * SG_G + SG_D;
        static_assert(DFF % 256 == 0 && DM % 256 == 0, "sample strides");
#pragma unroll 1
        for (int it = gw; it < DEPTH * SG_LAYER * 4; it += NGW) { const int q = it & 3; int g = it >> 2; const int l = g / SG_LAYER; g -= l * SG_LAYER; const int n = 4 * lane;
            if (g < SG_IN) { p0_sample_item(A->in[2] + (size_t)l * DM * INW + 2048, DM, INW, g * 256 + n, q, (unsigned*)(ws + WS_CMAX_IN) + (size_t)l * 8192, 8192, 0, 0); continue; } g -= SG_IN;
            if (g < SG_OUT) { p0_sample_item(A->in[6] + (size_t)l * DM * DM, DM, DM, g * 256 + n, q, (unsigned*)(ws + WS_CMAX_OUT) + (size_t)l * DM, DM, 0, 0); continue; } g -= SG_OUT;
            if (g < SG_G) { p0_sample_item(A->in[9] + (size_t)l * DM * DFF, DM, DFF, g * 256 + n, q, (unsigned*)(ws + WS_CMAX) + (size_t)l * NGU, 128, 256, 0); continue; } g -= SG_G;
            if (g < SG_G) { p0_sample_item(A->in[10] + (size_t)l * DM * DFF, DM, DFF, g * 256 + n, q, (unsigned*)(ws + WS_CMAX) + (size_t)l * NGU, 128, 256, 128); continue; } g -= SG_G;
            p0_sample_item(A->in[11] + (size_t)l * DFF * DM, DFF, DM, g * 256 + n, q, (unsigned*)(ws + WS_CMAX_DN) + (size_t)l * DM, DM, 0, 0); }
    } else {
        LAS float* scr = (LAS float*)(lds + RING_OFF + wave * 16384);
        constexpr int C_INB = 16 * (2048 / 64), C_IN8 = 16 * (8192 / 64), C_OUT = 16 * (DM / 64), C_G = 16 * (DFF / 64), C_D = 43 * (DM / 64), C_P = 4 * (256 / 64);
        constexpr int C_LAYER = C_INB + C_IN8 + C_OUT + 2 * C_G + C_D + C_P, C_HEAD = C_INB + C_IN8 + C_OUT;
        auto desc = [&](int it, int kt) -> TDesc {
            const int l = it / C_LAYER; int r = it - l * C_LAYER;
            unsigned char* wl = ws + WS_W + (size_t)l * W_LAYER;
            if (r < C_INB) return p0_tile_desc(A->in[2] + (size_t)l * DM * INW, DM, INW, 2048, wl + W_IN, 0, 2048, 0, 0, r, 4, kt, nullptr); r -= C_INB;
            if (r < C_IN8) return p0_tile_desc(A->in[2] + (size_t)l * DM * INW + 2048, DM, INW, 8192, wl + W_IN8, 1, 8192, 0, 0, r, 4, kt, (const unsigned*)(ws + WS_CMAX_IN) + (size_t)l * 8192); r -= C_IN8;
            if (r < C_OUT) return p0_tile_desc(A->in[6] + (size_t)l * DM * DM, DM, DM, DM, wl + W_OUT, 1, DM, 0, 0, r, 4, kt, (const unsigned*)(ws + WS_CMAX_OUT) + (size_t)l * DM); r -= C_OUT;
            if (r < C_G) return p0_tile_desc(A->in[9] + (size_t)l * DM * DFF, DM, DFF, DFF, wl + W_GU, 1, 128, 256, 0, r, 4, kt, (const unsigned*)(ws + WS_CMAX) + (size_t)l * NGU); r -= C_G;
            if (r < C_G) return p0_tile_desc(A->in[10] + (size_t)l * DM * DFF, DM, DFF, DFF, wl + W_GU, 1, 128, 256, 128, r, 4, kt, (const unsigned*)(ws + WS_CMAX) + (size_t)l * NGU); r -= C_G;
            if (r < C_D) return p0_tile_desc(A->in[11] + (size_t)l * DFF * DM, DFF, DM, DM, wl + W_DN, 2, DM, 0, 0, r, 4, kt, (const unsigned*)(ws + WS_CMAX_DN) + (size_t)l * DM); r -= C_D;
            const int g = r / 4, rr = r - g * 4;
            return p0_tile_desc(A->in[3] + (size_t)(l * 4 + g) * 256 * 256, 256, 256, 256, ws + WS_WP + (size_t)(l * 4 + g) * 256 * 256 * 2, 0, 256, 0, 0, rr, 4, kt, nullptr);
        };
        auto ntile = [&](int it) -> int { (void)it; return 4; };
        { constexpr int NIT = DEPTH * C_LAYER;
            auto gidx = [&](int j) -> int { return NIT - 1 - j; };
            int it = gw, kt = 0, nk = 0; f32x2_t va[32], vb[32]; float inv[8] = {0.f, 0.f, 0.f, 0.f, 0.f, 0.f, 0.f, 0.f}, invn[8] = {0.f, 0.f, 0.f, 0.f, 0.f, 0.f, 0.f, 0.f}; TDesc da, db;
            if (it < NIT) { nk = ntile(gidx(it)); da = desc(gidx(it), 0); p0_scale_load(da, inv, lane); p0_tile_load(da, va, lane); }
            while (it < NIT) {
                int itn = it, ktn = kt + 1, nkn = nk; if (ktn == nk) { itn = it + NGW; ktn = 0; if (itn < NIT) nkn = ntile(gidx(itn)); }
                if (itn < NIT) { db = desc(gidx(itn), ktn); if (itn != it) p0_scale_load(db, invn, lane); p0_tile_load(db, vb, lane); }
                p0_tile_store(da, va, scr, lane, inv); if (itn != it) { _Pragma("unroll") for (int e = 0; e < 8; ++e) inv[e] = invn[e]; }
                it = itn; kt = ktn; nk = nkn; if (it >= NIT) break;
                itn = it; ktn = kt + 1; nkn = nk; if (ktn == nk) { itn = it + NGW; ktn = 0; if (itn < NIT) nkn = ntile(gidx(itn)); }
                if (itn < NIT) { da = desc(gidx(itn), ktn); if (itn != it) p0_scale_load(da, invn, lane); p0_tile_load(da, va, lane); }
                p0_tile_store(db, vb, scr, lane, inv); if (itn != it) { _Pragma("unroll") for (int e = 0; e < 8; ++e) inv[e] = invn[e]; }
                it = itn; kt = ktn; nk = nkn; } }
        { LAS float* gl = (LAS float*)(lds + RING_OFF); __syncthreads(); stage_gains(gl, A->in[1], nullptr, tid_);
          _Pragma("unroll 1") for (int m = gw; m < M; m += NGW) rms_row_to_bf16(A->in[0] + (size_t)m * DM, gl, (bf16*)(ws + WS_H) + (size_t)m * DM, ws + WS_H8 + (size_t)m * DM, (float*)(ws + WS_HS) + m, lane); }
    }
}
__global__ void __launch_bounds__(NWAVES * 64, 2) hybrid_fwd(Args args_unused) {
    extern __shared__ __attribute__((aligned(16))) unsigned char lds_raw[];
    LAS unsigned char* lds = (LAS unsigned char*)lds_raw;
    for (int u = threadIdx.x; u < (LDS_BYTES - LDSCTL_OFF) / 4; u += NWAVES * 64) ((LAS unsigned*)(lds + LDSCTL_OFF))[u] = 0u;
    __syncthreads();
    if (MK_N_LAUNCHES == 1) (void)xcd_barrier_post((unsigned*)((gu32*)(kargs()->ws + WS_CTL) + CW_BAR), (volatile LAS unsigned*)(lds + MISC_OFF) + 8);
#define GRID_BAR() do { if (MK_N_LAUNCHES == 1) { XcdBarrier bar_; bar_.bar = (unsigned*)((gu32*)(kargs()->ws + WS_CTL) + CW_BAR); bar_.x = xb_xcc_id(); bar_.st = (volatile LAS unsigned*)(lds + MISC_OFF) + 8; xcd_barrier(bar_); } } while (0)
#define IN(k) (A->ph_lo <= (k) && (k) < A->ph_hi)
#define BOTH(k) (IN(k) && IN((k) + 1))
#define PHASE_ENV() const KArgs A = kargs(); unsigned char* const ws = A->ws; int tid_ = threadIdx.x; asm volatile("" : "+v"(tid_)); const int lane = tid_ & 63, wave = __builtin_amdgcn_readfirstlane(tid_ >> 6); const int G = gridDim.x, vcu = vcu_of(G); \
    const int gw = vcu * NWAVES + wave, NGW = G * NWAVES; (void)lane; (void)gw; (void)NGW; (void)ws

    { PHASE_ENV(); if (IN(0)) { p0_work<0>(A, ws, lds, lane, wave, gw, NGW, tid_); if (BOTH(0)) GRID_BAR(); } }
    { PHASE_ENV(); if (IN(1)) { p0_work<1>(A, ws, lds, lane, wave, gw, NGW, tid_); if (BOTH(1)) GRID_BAR(); } }

    for (int l = 0; l < DEPTH; ++l) {
        const int pb = 2 + 8 * l;
        { PHASE_ENV();
        if (IN(pb + 0)) {
            { pg8::Gemm g{(const bf16*)(ws + WS_H), (const bf16*)(ws + WS_W + (size_t)l * W_LAYER + W_IN), M, 2048, DM}; pg8::StaticOrder S; S.init(M, 2048, G, (int)blockIdx.x);
              pg8::EpiProj E{(bf16*)(ws + WS_PROJ), INW, (float*)(ws + WS_KSUM) + (size_t)l * 32 * 1024};
              GEMM1(pg8::gemm_phase<pg8::EpiProj, pg8::StaticOrder, true, true>(lds + RING_OFF, g, S, E);) }
            { pg8::Gemm g{(const bf16*)(ws + WS_H8), (const bf16*)(ws + WS_W + (size_t)l * W_LAYER + W_IN8), M, 8192, DM / 2}; pg8::StaticOrder S; S.init(M, 8192, G, (int)blockIdx.x);
              pg8::EpiProj8 E{(bf16*)(ws + WS_PROJ), INW, 2048, (const float*)(ws + WS_HS), (const float*)(ws + WS_CMAX_IN) + (size_t)l * 8192};
              GEMM1(pg8::gemm_phase<pg8::EpiProj8, pg8::StaticOrder, false, true, 1>(lds + RING_OFF, g, S, E);) }
            if (BOTH(pb + 0)) GRID_BAR();
        } }
        { PHASE_ENV();
        if (IN(pb + 1)) {
            LAS char* alds = (LAS char*)(lds + RING_OFF);
            const bf16* PROJ = (const bf16*)(ws + WS_PROJ); bf16* Yb = (bf16*)(ws + WS_Y); const float* ksum = (const float*)(ws + WS_KSUM) + (size_t)l * 32 * 1024;
            for (int w = vcu; w < 256; w += G) {
                const int idx = w & 127, bh = idx >> 2, p = idx & 3;
                const int sub = A->sub;
                ATT0(if (w < 128 && (sub & 1)) { for (int ps = 0; ps < 2; ++ps) att::attn_block<0>(PROJ, Yb, ksum, bh >> 3, bh & 7, ps ? p : 7 - p, alds); })
                ATT1(if (w >= 128 && (sub & 2)) { for (int ps = 0; ps < 2; ++ps) att::attn_block<1>(PROJ, Yb, ksum, bh >> 3, bh & 7, ps ? p : 7 - p, alds); })
                ATT2(if (sub & 4) { const int bh2 = w >> 3; att::attn_block<2>(PROJ, Yb, ksum, bh2 >> 3, bh2 & 7, w & 7, alds); })
                POOL(if (w < 128 && (sub & 8)) { for (int pi = 0; pi < 2; ++pi) { const int it = w + 128 * pi; att::pool_item(PROJ, (const bf16*)(ws + WS_WP) + (size_t)l * 4 * 256 * 256, A->in[4] + (size_t)l * GW, Yb, it >> 6, it & 63, alds); } })
            }
            if (BOTH(pb + 1)) GRID_BAR();
        } }
        { PHASE_ENV();
        if (IN(pb + 2)) {
            LAS float* gl = (LAS float*)(lds + RING_OFF); stage_gains(gl, A->in[5] + (size_t)l * DM, nullptr, tid_);
            _Pragma("unroll 1") for (int m = gw; m < M; m += NGW) mixnorm_row((const bf16*)(ws + WS_Y) + (size_t)m * DM, gl, ws + WS_YN + (size_t)m * DM, (float*)(ws + WS_YS) + m, lane);
            if (BOTH(pb + 2)) GRID_BAR();
        } }
        { PHASE_ENV();
        if (IN(pb + 3)) {
            pg8::Gemm g{(const bf16*)(ws + WS_YN), (const bf16*)(ws + WS_W + (size_t)l * W_LAYER + W_OUT), M, DM, DM / 2}; pg8::StaticOrder S; S.init(M, DM, G, (int)blockIdx.x);
            pg8::EpiF32S E{(bf16*)(ws + WS_MF), DM, (const float*)(ws + WS_YS), (const float*)(ws + WS_CMAX_OUT) + (size_t)l * DM};
            GEMM2(pg8::gemm_phase<pg8::EpiF32S, pg8::StaticOrder, false, true, 1>(lds + RING_OFF, g, S, E);)
            if (BOTH(pb + 3)) GRID_BAR();
        } }
        { PHASE_ENV();
        if (IN(pb + 4)) {
            bf16* XS = (bf16*)(ws + WS_XS); LAS float* gl = (LAS float*)(lds + RING_OFF);
            stage_gains(gl, A->in[7] + (size_t)l * DM, A->in[8] + (size_t)l * DM, tid_);
            if (l == 0) { _Pragma("unroll 1") for (int m = gw; m < M; m += NGW) resid_row<true, false, true>((const bf16*)(ws + WS_MF) + (size_t)m * DM, A->in[0] + (size_t)m * DM, gl, XS + (size_t)m * DM, nullptr, ws + WS_H8 + (size_t)m * DM, (float*)(ws + WS_HS) + m, lane); }
            else { _Pragma("unroll 1") for (int m = gw; m < M; m += NGW) resid_row<false, false, true>((const bf16*)(ws + WS_MF) + (size_t)m * DM, XS + (size_t)m * DM, gl, XS + (size_t)m * DM, nullptr, ws + WS_H8 + (size_t)m * DM, (float*)(ws + WS_HS) + m, lane); }
            if (BOTH(pb + 4)) GRID_BAR();
        } }
        { PHASE_ENV();
        if (IN(pb + 5)) {
            pg8::Gemm g{(const bf16*)(ws + WS_H8), (const bf16*)(ws + WS_W + (size_t)l * W_LAYER + W_GU), M, NGU, DM / 2}; pg8::StaticOrder S; S.init(M, NGU, G, (int)blockIdx.x);
            pg8::EpiSwiGLU8 E{ws + WS_ACT, DFF, (const float*)(ws + WS_HS), (const float*)(ws + WS_CMAX) + (size_t)l * NGU};
            GEMM3(pg8::gemm_phase<pg8::EpiSwiGLU8, pg8::StaticOrder, false, true, 1>(lds + RING_OFF, g, S, E);)
            if (BOTH(pb + 5)) GRID_BAR();
        } }
        { PHASE_ENV();
        if (IN(pb + 6)) {
            pg8::Gemm g{(const bf16*)(ws + WS_ACT), (const bf16*)(ws + WS_W + (size_t)l * W_LAYER + W_DN), M, DM, DFF / 2}; pg8::StaticOrder S; S.init(M, DM, G, (int)blockIdx.x);
            pg8::EpiF32C E{(bf16*)(ws + WS_MF), DM, (const float*)(ws + WS_CMAX_DN) + (size_t)l * DM};
            GEMM2(pg8::gemm_phase<pg8::EpiF32C, pg8::StaticOrder, false, true, 2>(lds + RING_OFF, g, S, E);)
            if (BOTH(pb + 6)) GRID_BAR();
        } }
        { PHASE_ENV();
        if (IN(pb + 7)) {
            bf16* XS = (bf16*)(ws + WS_XS); LAS float* gl = (LAS float*)(lds + RING_OFF);
            stage_gains(gl, A->in[12] + (size_t)l * DM, (l + 1 < DEPTH) ? A->in[1] + (size_t)(l + 1) * DM : nullptr, tid_);
            if (l + 1 < DEPTH) { _Pragma("unroll 1") for (int m = gw; m < M; m += NGW) resid_row<false, false, true>((const bf16*)(ws + WS_MF) + (size_t)m * DM, XS + (size_t)m * DM, gl, XS + (size_t)m * DM, (bf16*)(ws + WS_H) + (size_t)m * DM, ws + WS_H8 + (size_t)m * DM, (float*)(ws + WS_HS) + m, lane); }
            else { _Pragma("unroll 1") for (int m = gw; m < M; m += NGW) resid_row<false, true, false>((const bf16*)(ws + WS_MF) + (size_t)m * DM, XS + (size_t)m * DM, gl, A->out + (size_t)m * DM, nullptr, nullptr, nullptr, lane); }
            if (BOTH(pb + 7)) GRID_BAR();
        } }
    }
#undef IN
#undef BOTH
#undef GRID_BAR
#undef PHASE_ENV
}

#ifndef PROBE_DUP_MASK
#define PROBE_DUP_MASK 0ull
#endif
#ifndef PROBE_EXTRA
#define PROBE_EXTRA 1
#endif
#ifndef PROBE_SUB
#define PROBE_SUB 0
#endif
#ifndef PROBE_PAIR01
#define PROBE_PAIR01 0
#endif
extern "C" void kernel_launch(void* const* d_in, const int* in_sizes, int n_in, void* d_out, int out_size, void* d_ws, size_t ws_size, hipStream_t stream) {
    static int grid = 0;
    if (grid == 0) {
        if (n_in != 13 || in_sizes[0] != M * DM || out_size != M * DM || ws_size < WS_END) { fprintf(stderr, "kernel_launch: shape/workspace mismatch (n_in %d, in0 %d, out %d, ws %zu, need %zu); nothing launched\n", n_in, n_in > 0 ? in_sizes[0] : -1, out_size, ws_size, (size_t)WS_END); grid = -1; return; }
        int dev = 0, cus = 0, per_cu = 0;
        if (hipGetDevice(&dev) != hipSuccess || hipDeviceGetAttribute(&cus, hipDeviceAttributeMultiprocessorCount, dev) != hipSuccess) { fprintf(stderr, "kernel_launch: device query failed\n"); grid = -1; return; }
        if (hipFuncSetAttribute((const void*)hybrid_fwd, hipFuncAttributeMaxDynamicSharedMemorySize, LDS_BYTES) != hipSuccess) { fprintf(stderr, "kernel_launch: hipFuncSetAttribute failed\n"); grid = -1; return; }
        if (hipOccupancyMaxActiveBlocksPerMultiprocessor(&per_cu, (const void*)hybrid_fwd, NWAVES * 64, LDS_BYTES) != hipSuccess || per_cu < 1)
            fprintf(stderr, "kernel_launch: note: the occupancy query reports %d workgroups per CU\n", per_cu);
        (void)hipGetLastError();
        grid = cus;
    }
    if (grid < 0) return;
    if (hipMemsetAsync((char*)d_ws + WS_CTL, 0, CTL_ZERO_BYTES, stream) != hipSuccess) { fprintf(stderr, "kernel_launch: hipMemsetAsync failed\n"); return; }
    Args a{};
    for (int i = 0; i < 13; ++i) a.in[i] = (const float*)d_in[i];
    a.out = (float*)d_out; a.ws = (unsigned char*)d_ws; a.sub = 15; a.pad = 0;
    if (MK_N_LAUNCHES == 1) {
        a.ph_lo = 0; a.ph_hi = NPHASE;
        hipLaunchKernelGGL(hybrid_fwd, dim3(grid), dim3(NWAVES * 64), LDS_BYTES, stream, a);
    } else {
        for (int k = 0; k < NPHASE; ++k) { a.ph_lo = k; a.ph_hi = k + 1; const int reps = 1 + (int)((PROBE_DUP_MASK >> k) & 1ull) * PROBE_EXTRA;
            for (int r = 0; r < reps; ++r) hipLaunchKernelGGL(hybrid_fwd, dim3(grid), dim3(NWAVES * 64), LDS_BYTES, stream, a);
            if (PROBE_PAIR01 && k == 1) { for (int r = 0; r < PROBE_EXTRA; ++r) for (int k2 = 0; k2 < 2; ++k2) { a.ph_lo = k2; a.ph_hi = k2 + 1; hipLaunchKernelGGL(hybrid_fwd, dim3(grid), dim3(NWAVES * 64), LDS_BYTES, stream, a); } a.ph_lo = k; a.ph_hi = k + 1; }
            if (PROBE_SUB && k == 3) { a.sub = PROBE_SUB; for (int r = 0; r < PROBE_EXTRA; ++r) hipLaunchKernelGGL(hybrid_fwd, dim3(grid), dim3(NWAVES * 64), LDS_BYTES, stream, a); a.sub = 15; } }
    }
    const hipError_t le = hipPeekAtLastError();
    if (le != hipSuccess) fprintf(stderr, "kernel_launch: launch failed: %s\n", hipGetErrorName(le));
}
```
